# Optimizing an MI355X kernel written in HIP

```python
import jax, jax.numpy as jnp
from jax import lax
import numpy as np

D_MODEL = 1024
BATCH = 2
SEQ = 8192
DEPTH = 1

CHUNK = 64
Q_BLOCK = 128
EPS = 1e-6

D_MIX = D_MODEL
SB_WIDTH = D_MIX // 2
SB_HEADS = 8
SB_HEAD_DIM = SB_WIDTH // SB_HEADS
GLA_WIDTH = D_MIX - SB_WIDTH
GLA_HEADS = 4
GLA_DV = GLA_WIDTH // GLA_HEADS
GLA_DK = GLA_DV // 2
GLA_KEY_WIDTH = GLA_HEADS * GLA_DK
GLA_GATE_RANK = 16
GLA_GATE_TAU = 16.0

IN_SIZES = (SB_WIDTH, SB_WIDTH, SB_WIDTH,
            GLA_KEY_WIDTH, GLA_KEY_WIDTH, GLA_WIDTH,
            GLA_GATE_RANK,
            GLA_WIDTH)
D_IN_PROJ = SB_WIDTH * 3 + GLA_KEY_WIDTH * 2 + GLA_WIDTH + GLA_GATE_RANK + GLA_WIDTH

PEER_HEADS = 8
PEER_N_KEYS = 128
PEER_N_EXPERTS = PEER_N_KEYS * PEER_N_KEYS
PEER_QUERY_DIM = 256
PEER_HALF = PEER_QUERY_DIM // 2
PEER_TOPK = 16
PEER_TOKEN_BLOCK = 128

kernel_name = "hybrid_sb_gla_peer_adaln_block"


def _rms(x):
    x32 = x.astype(jnp.float32)
    return (x32 * lax.rsqrt(jnp.mean(x32 * x32, axis=-1, keepdims=True) + EPS)).astype(x.dtype)


def _split_cols(t, sizes):
    outs, start = [], 0
    for s in sizes:
        outs.append(t[..., start:start + s])
        start += s
    return outs


def _heads(t, n_heads):
    b, s, _ = t.shape
    return t.reshape(b, s, n_heads, -1).transpose(0, 2, 1, 3)


def _merge_heads(t):
    b, n, s, d = t.shape
    return t.transpose(0, 2, 1, 3).reshape(b, s, n * d)


def stick_breaking_attention(q, k, v):
    b, h, s, dh = q.shape
    scale = dh ** -0.5
    n_blocks = s // Q_BLOCK
    key_pos = jnp.arange(s)

    def block(i):
        start = i * Q_BLOCK
        qb = lax.dynamic_slice_in_dim(q, start, Q_BLOCK, axis=2)
        z = jnp.einsum('bhtd,bhsd->bhts', qb, k).astype(jnp.float32) * scale
        q_pos = start + jnp.arange(Q_BLOCK)
        causal = key_pos[None, :] < q_pos[:, None]
        log_beta = jax.nn.log_sigmoid(z)
        log_keep = jnp.where(causal, jax.nn.log_sigmoid(-z), 0.0)
        suffix = lax.cumsum(log_keep, axis=3, reverse=True) - log_keep
        w = jnp.where(causal, jnp.exp(log_beta + suffix), 0.0)
        return jnp.einsum('bhts,bhsd->bhtd', w.astype(v.dtype), v)

    out = lax.map(block, jnp.arange(n_blocks))
    return out.transpose(1, 2, 0, 3, 4).reshape(b, h, s, dh)


def gla_chunked(q, k, v, log_a):
    b, h, s, dk = q.shape
    dv = v.shape[-1]
    n_chunks = s // CHUNK

    def to_chunks(t):
        return t.reshape(b, h, n_chunks, CHUNK, t.shape[-1]).transpose(2, 0, 1, 3, 4)

    qc, kc, vc, gc = (to_chunks(t) for t in (q * (dk ** -0.5), k, v, log_a))
    tri = jnp.tril(jnp.ones((CHUNK, CHUNK), dtype=bool))

    def step(state, inp):
        qi, ki, vi, gi = inp
        bcum = jnp.cumsum(gi.astype(jnp.float32), axis=2)
        b_last = bcum[:, :, -1:, :]
        diff = bcum[:, :, :, None, :] - bcum[:, :, None, :, :]
        decay = jnp.exp(jnp.where(tri[:, :, None], diff, -jnp.inf))
        scores = jnp.einsum('bhtd,bhsd,bhtsd->bhts', qi.astype(jnp.float32), ki.astype(jnp.float32), decay)
        o_intra = jnp.einsum('bhts,bhsv->bhtv', scores, vi.astype(jnp.float32))
        o_inter = jnp.einsum('bhtd,bhdv->bhtv', qi.astype(jnp.float32) * jnp.exp(bcum), state)
        k_dec = ki.astype(jnp.float32) * jnp.exp(b_last - bcum)
        new_state = state * jnp.exp(b_last[:, :, 0, :])[..., None] + jnp.einsum('bhsd,bhsv->bhdv', k_dec, vi.astype(jnp.float32))
        return new_state, o_intra + o_inter

    s0 = jnp.zeros((b, h, dk, dv), jnp.float32)
    _, out = lax.scan(step, s0, (qc, kc, vc, gc))
    return out.transpose(1, 2, 0, 3, 4).reshape(b, h, s, dv).astype(v.dtype)


def _head_rms(t, gain, n_heads):
    b, s, w = t.shape
    return _rms(t.reshape(b, s, n_heads, w // n_heads)).reshape(b, s, w) * gain


def peer_layer(h, w_q, keys_a, keys_b, expert_u, expert_v):
    t_tot, d = h.shape
    q = (h @ w_q).reshape(t_tot, PEER_HEADS, PEER_QUERY_DIM)
    q1, q2 = q[..., :PEER_HALF], q[..., PEER_HALF:]
    s1 = jnp.einsum('thd,hkd->thk', q1, keys_a)
    s2 = jnp.einsum('thd,hkd->thk', q2, keys_b)
    v1, i1 = lax.top_k(s1, PEER_TOPK)
    v2, i2 = lax.top_k(s2, PEER_TOPK)
    cand_s = (v1[..., :, None] + v2[..., None, :]).reshape(t_tot, PEER_HEADS, PEER_TOPK * PEER_TOPK)
    cand_i = (i1[..., :, None] * PEER_N_KEYS + i2[..., None, :]).reshape(t_tot, PEER_HEADS, PEER_TOPK * PEER_TOPK)
    top_s, pos = lax.top_k(cand_s, PEER_TOPK)
    idx = jnp.take_along_axis(cand_i, pos, axis=-1)
    gates = jax.nn.softmax(top_s.astype(jnp.float32), axis=-1).astype(h.dtype)

    n_blocks = t_tot // PEER_TOKEN_BLOCK

    def block(args):
        hb, ib, gb = args
        u = expert_u[ib]
        act = jax.nn.gelu(jnp.einsum('td,thkd->thk', hb, u), approximate=False)
        vv = expert_v[ib]
        return jnp.einsum('thk,thkd->td', gb * act, vv)

    out = lax.map(block, (h.reshape(n_blocks, PEER_TOKEN_BLOCK, d),
                          idx.reshape(n_blocks, PEER_TOKEN_BLOCK, PEER_HEADS, PEER_TOPK),
                          gates.reshape(n_blocks, PEER_TOKEN_BLOCK, PEER_HEADS, PEER_TOPK)))
    return out.reshape(t_tot, d)


def setup_inputs(seed: int = 0) -> dict:
    key = jax.random.key(seed)
    ks = jax.random.split(key, 16)
    d = D_MODEL
    nrm = jax.random.normal
    return {
        "x": nrm(ks[0], (BATCH, SEQ, d), jnp.float32),
        "c": nrm(ks[1], (BATCH, d), jnp.float32),
        "w_ada": nrm(ks[2], (DEPTH, d, 6 * d), jnp.float32) * (0.5 * d ** -0.5),
        "b_ada": nrm(ks[3], (DEPTH, 6 * d), jnp.float32) * 0.05,
        "w_in": nrm(ks[4], (DEPTH, d, D_IN_PROJ), jnp.float32) * d ** -0.5,
        "w_gla_gate_up": nrm(ks[5], (DEPTH, GLA_GATE_RANK, GLA_KEY_WIDTH), jnp.float32) * GLA_GATE_RANK ** -0.5,
        "b_gla_gate": nrm(ks[6], (DEPTH, GLA_KEY_WIDTH), jnp.float32) * 0.1,
        "g_sb_norm": 1.0 + 0.02 * nrm(ks[7], (DEPTH, SB_WIDTH), jnp.float32),
        "g_gla_norm": 1.0 + 0.02 * nrm(ks[8], (DEPTH, GLA_WIDTH), jnp.float32),
        "w_out": nrm(ks[9], (DEPTH, D_MIX, d), jnp.float32) * D_MIX ** -0.5,
        "w_peer_q": nrm(ks[10], (DEPTH, d, PEER_HEADS * PEER_QUERY_DIM), jnp.float32) * d ** -0.5,
        "peer_keys_a": nrm(ks[11], (DEPTH, PEER_HEADS, PEER_N_KEYS, PEER_HALF), jnp.float32) * PEER_HALF ** -0.5,
        "peer_keys_b": nrm(ks[12], (DEPTH, PEER_HEADS, PEER_N_KEYS, PEER_HALF), jnp.float32) * PEER_HALF ** -0.5,
        "peer_u": nrm(ks[13], (DEPTH, PEER_N_EXPERTS, d), jnp.float32) * d ** -0.5,
        "peer_v": nrm(ks[14], (DEPTH, PEER_N_EXPERTS, d), jnp.float32) * PEER_HEADS ** -0.5,
        "g_final": 1.0 + 0.02 * nrm(ks[15], (d,), jnp.float32),
    }


def reference(x, c, w_ada, b_ada, w_in, w_gla_gate_up, b_gla_gate, g_sb_norm, g_gla_norm,
              w_out, w_peer_q, peer_keys_a, peer_keys_b, peer_u, peer_v, g_final):
    b, s, d = x.shape
    c_act = jax.nn.silu(c)
    for l in range(DEPTH):
        mod = (c_act @ w_ada[l] + b_ada[l])[:, None, :]
        shift1, scale1, gate1, shift2, scale2, gate2 = _split_cols(mod, (d,) * 6)

        h = _rms(x) * (1.0 + scale1) + shift1
        proj = h @ w_in[l]
        sb_q, sb_k, sb_v, g_q, g_k, g_v, g_lr, g_r = _split_cols(proj, IN_SIZES)

        sb_out = stick_breaking_attention(_heads(sb_q, SB_HEADS), _heads(sb_k, SB_HEADS), _heads(sb_v, SB_HEADS))
        sb_out = _head_rms(_merge_heads(sb_out), g_sb_norm[l], SB_HEADS)

        log_a = jax.nn.log_sigmoid((g_lr @ w_gla_gate_up[l] + b_gla_gate[l]).astype(jnp.float32)) / GLA_GATE_TAU
        gla_out = gla_chunked(_heads(g_q, GLA_HEADS), _heads(g_k, GLA_HEADS), _heads(g_v, GLA_HEADS),
                              _heads(log_a, GLA_HEADS))
        gla_out = _head_rms(_merge_heads(gla_out), g_gla_norm[l], GLA_HEADS) * jax.nn.silu(g_r)

        mixed = jnp.concatenate([sb_out, gla_out], axis=-1) @ w_out[l]
        x = x + gate1 * mixed

        h2 = _rms(x) * (1.0 + scale2) + shift2
        y = peer_layer(h2.reshape(b * s, d), w_peer_q[l], peer_keys_a[l], peer_keys_b[l], peer_u[l], peer_v[l])
        x = x + gate2 * y.reshape(b, s, d)
    return _rms(x) * g_final
```

```cpp
#include <hip/hip_runtime.h>
#include <hip/hip_cooperative_groups.h>
#include <cstdio>
#include <cstdint>
namespace cg = cooperative_groups;

#ifndef FUSED
#define FUSED 1
#endif

constexpr int T = 16384, D = 1024, SEQ = 8192, NPROJ = 3088, NT = 512;
constexpr int OFF_SBQ = 0, OFF_SBK = 512, OFF_SBV = 1024, OFF_GQ = 1536, OFF_GK = 1792, OFF_GV = 2048, OFF_GLR = 2560, OFF_GR = 2576;
constexpr float EPS = 1e-6f;
constexpr size_t MiB = 1u << 20;

struct Params {
    const float *x, *c, *w_ada, *b_ada, *w_in, *w_up, *b_gate, *g_sb, *g_gla, *w_out, *w_pq, *keys_a, *keys_b, *pu, *pv, *g_final;
    float* out; unsigned char* ws;
};

__device__ __forceinline__ float wave_sum(float v) {
#pragma unroll
    for (int o = 32; o > 0; o >>= 1) v += __shfl_xor(v, o);
    return v;
}
__device__ __forceinline__ float softplusf(float z) { return fmaxf(z, 0.f) + log1pf(expf(-fabsf(z))); }
__device__ __forceinline__ float siluf(float v) { return v / (1.f + expf(-v)); }

__device__ __forceinline__ float* ws_mod(const Params& p) { return (float*)(p.ws); }
__device__ __forceinline__ float* ws_proj(const Params& p) { return (float*)(p.ws + 1 * MiB); }
__device__ __forceinline__ float* ws_x1(const Params& p) { return (float*)(p.ws + 1 * MiB); }
__device__ __forceinline__ float* ws_qp(const Params& p) { return (float*)(p.ws + 65 * MiB); }
__device__ __forceinline__ int* ws_idx(const Params& p) { return (int*)(p.ws + 194 * MiB); }
__device__ __forceinline__ float* ws_gate(const Params& p) { return (float*)(p.ws + 202 * MiB); }

template <class Epi>
__device__ void gemm_f32(const float* A, const float* B, int M, int N, int K, int bid, int nb, unsigned char* smem, Epi epi) {
    float (*As)[132] = (float (*)[132])smem;
    float (*Bs)[64] = (float (*)[64])(smem + 16 * 132 * 4);
    const int tid = threadIdx.x, ty = tid >> 4, tx = tid & 15;
    const int tn = (N + 63) / 64, tm = M / 128;
    for (int unit = bid; unit < tm * tn; unit += nb) {
        const int m0 = (unit / tn) * 128, n0 = (unit % tn) * 64;
        float acc[4][4];
#pragma unroll
        for (int i = 0; i < 4; ++i)
#pragma unroll
            for (int j = 0; j < 4; ++j) acc[i][j] = 0.f;
        for (int k0 = 0; k0 < K; k0 += 16) {
            {
                const int r = tid >> 2, kq = (tid & 3) * 4;
                const float4 v = *(const float4*)(A + (size_t)(m0 + r) * K + k0 + kq);
                As[kq + 0][r] = v.x; As[kq + 1][r] = v.y; As[kq + 2][r] = v.z; As[kq + 3][r] = v.w;
            }
            if (tid < 256) {
                const int kr = tid >> 4, nq = (tid & 15) * 4;
                float4 v = make_float4(0.f, 0.f, 0.f, 0.f);
                if (n0 + nq < N) v = *(const float4*)(B + (size_t)(k0 + kr) * N + n0 + nq);
                *(float4*)&Bs[kr][nq] = v;
            }
            __syncthreads();
#pragma unroll
            for (int kk = 0; kk < 16; ++kk) {
                const float4 a = *(const float4*)&As[kk][ty * 4];
                const float4 b = *(const float4*)&Bs[kk][tx * 4];
                const float av[4] = {a.x, a.y, a.z, a.w}, bv[4] = {b.x, b.y, b.z, b.w};
#pragma unroll
                for (int i = 0; i < 4; ++i)
#pragma unroll
                    for (int j = 0; j < 4; ++j) acc[i][j] += av[i] * bv[j];
            }
            __syncthreads();
        }
#pragma unroll
        for (int i = 0; i < 4; ++i)
#pragma unroll
            for (int j = 0; j < 4; ++j) {
                const int r = m0 + ty * 4 + i, cidx = n0 + tx * 4 + j;
                if (cidx < N) epi(r, cidx, acc[i][j]);
            }
    }
}

__device__ void phase_mod(const Params& p, int bid, int nb) {
    float* mod = ws_mod(p);
    for (int n = bid * NT + threadIdx.x; n < 6 * D; n += nb * NT) {
        float a0 = 0.f, a1 = 0.f;
        for (int k = 0; k < D; ++k) {
            const float w = p.w_ada[(size_t)k * 6 * D + n];
            a0 += siluf(p.c[k]) * w; a1 += siluf(p.c[D + k]) * w;
        }
        mod[n] = a0 + p.b_ada[n]; mod[6 * D + n] = a1 + p.b_ada[n];
    }
}
__device__ void phase_norm_mod(const Params& p, const float* src, float* dst, int shift_off, int scale_off, int bid, int nb) {
    const float* mod = ws_mod(p);
    const int lane = threadIdx.x & 63, wave = threadIdx.x >> 6;
    for (int row = bid * 8 + wave; row < T; row += nb * 8) {
        const int b = row / SEQ;
        const float4* xr = (const float4*)(src + (size_t)row * D);
        float4 v[4]; float ss = 0.f;
#pragma unroll
        for (int j = 0; j < 4; ++j) { v[j] = xr[j * 64 + lane]; ss += v[j].x * v[j].x + v[j].y * v[j].y + v[j].z * v[j].z + v[j].w * v[j].w; }
        ss = wave_sum(ss);
        const float r = rsqrtf(ss * (1.f / D) + EPS);
        float4* orow = (float4*)(dst + (size_t)row * D);
#pragma unroll
        for (int j = 0; j < 4; ++j) {
            const int col = (j * 64 + lane) * 4;
            const float4 sc = *(const float4*)(mod + b * 6 * D + scale_off + col), sh = *(const float4*)(mod + b * 6 * D + shift_off + col);
            float4 o;
            o.x = v[j].x * r * (1.f + sc.x) + sh.x; o.y = v[j].y * r * (1.f + sc.y) + sh.y;
            o.z = v[j].z * r * (1.f + sc.z) + sh.z; o.w = v[j].w * r * (1.f + sc.w) + sh.w;
            orow[j * 64 + lane] = o;
        }
    }
}
__device__ void phase_sb(const Params& p, float* mixin, int bid, int nb) {
    const float* proj = ws_proj(p);
    for (int g = bid * NT + threadIdx.x; g < 2 * 8 * SEQ; g += nb * NT) {
        const int t = g % SEQ, h = (g / SEQ) % 8, b = g / (8 * SEQ);
        const size_t tok = (size_t)b * SEQ + t;
        float q[64], o[64];
        const float* qr = proj + tok * NPROJ + OFF_SBQ + h * 64;
#pragma unroll
        for (int d = 0; d < 64; ++d) { q[d] = qr[d] * 0.125f; o[d] = 0.f; }
        float carry = 0.f;
        for (int s = t - 1; s >= 0; --s) {
            const float* kr = proj + ((size_t)b * SEQ + s) * NPROJ + OFF_SBK + h * 64;
            const float* vr = proj + ((size_t)b * SEQ + s) * NPROJ + OFF_SBV + h * 64;
            float z = 0.f;
#pragma unroll
            for (int d = 0; d < 64; ++d) z += q[d] * kr[d];
            const float lb = -softplusf(-z);
            const float w = expf(lb + carry);
#pragma unroll
            for (int d = 0; d < 64; ++d) o[d] += w * vr[d];
            carry -= softplusf(z);
            if (carry < -104.f) break;
        }
        float ss = 0.f;
#pragma unroll
        for (int d = 0; d < 64; ++d) ss += o[d] * o[d];
        const float r = rsqrtf(ss * (1.f / 64.f) + EPS);
        float* orow = mixin + tok * D + h * 64;
#pragma unroll
        for (int d = 0; d < 64; ++d) orow[d] = o[d] * r * p.g_sb[h * 64 + d];
    }
}
__device__ void phase_gla(const Params& p, float* mixin, int bid, int nb, unsigned char* smem) {
    const float* proj = ws_proj(p);
    float (*a_l)[64] = (float (*)[64])smem;
    float (*k_l)[64] = (float (*)[64])(smem + 4096);
    float (*q_l)[64] = (float (*)[64])(smem + 8192);
    float (*po)[4][128] = (float (*)[4][128])(smem + 12288);
    const int tid = threadIdx.x, dv = tid & 127, dq = tid >> 7, lane = tid & 63, wave = tid >> 6;
    for (int bh = bid; bh < 8; bh += nb) {
        const int b = bh >> 2, h = bh & 3;
        float s[16];
#pragma unroll
        for (int i = 0; i < 16; ++i) s[i] = 0.f;
        for (int t0 = 0; t0 < SEQ; t0 += 16) {
            for (int idx = tid; idx < 16 * 64; idx += NT) {
                const int tt = idx >> 6, d = idx & 63;
                const float* pr = proj + ((size_t)b * SEQ + t0 + tt) * NPROJ;
                float xg = p.b_gate[h * 64 + d];
#pragma unroll
                for (int r = 0; r < 16; ++r) xg += pr[OFF_GLR + r] * p.w_up[r * 256 + h * 64 + d];
                a_l[tt][d] = expf(-softplusf(-xg) * (1.f / 16.f));
                k_l[tt][d] = pr[OFF_GK + h * 64 + d];
                q_l[tt][d] = pr[OFF_GQ + h * 64 + d] * 0.125f;
            }
            __syncthreads();
            for (int tt = 0; tt < 16; ++tt) {
                const float v = proj[((size_t)b * SEQ + t0 + tt) * NPROJ + OFF_GV + h * 128 + dv];
                float part = 0.f;
#pragma unroll
                for (int i = 0; i < 16; ++i) {
                    const int d = dq * 16 + i;
                    s[i] = a_l[tt][d] * s[i] + k_l[tt][d] * v;
                    part += q_l[tt][d] * s[i];
                }
                po[tt][dq][dv] = part;
            }
            __syncthreads();
            for (int tt = wave; tt < 16; tt += 8) {
                const size_t tok = (size_t)b * SEQ + t0 + tt;
                const float o0 = po[tt][0][lane] + po[tt][1][lane] + po[tt][2][lane] + po[tt][3][lane];
                const float o1 = po[tt][0][lane + 64] + po[tt][1][lane + 64] + po[tt][2][lane + 64] + po[tt][3][lane + 64];
                const float ss = wave_sum(o0 * o0 + o1 * o1);
                const float r = rsqrtf(ss * (1.f / 128.f) + EPS);
                const float* gr = proj + tok * NPROJ + OFF_GR + h * 128;
                float* orow = mixin + tok * D + 512 + h * 128;
                orow[lane] = o0 * r * p.g_gla[h * 128 + lane] * siluf(gr[lane]);
                orow[lane + 64] = o1 * r * p.g_gla[h * 128 + lane + 64] * siluf(gr[lane + 64]);
            }
        }
        __syncthreads();
    }
}
__device__ void phase_topk(const Params& p, int bid, int nb, unsigned char* smem) {
    const float* qp = ws_qp(p);
    int* idx = ws_idx(p); float* gate = ws_gate(p);
    const int tid = threadIdx.x, hb = tid >> 8, i = tid & 255;
    float (*sc)[256] = (float (*)[256])smem;
    float (*topv)[2][16] = (float (*)[2][16])(smem + 2048);
    int (*topi)[2][16] = (int (*)[2][16])(smem + 2048 + 256);
    float (*cand)[256] = (float (*)[256])(smem + 4096);
    float (*fs)[16] = (float (*)[16])(smem + 8192);
    int (*fi)[16] = (int (*)[16])(smem + 8192 + 128);
    for (int unit = bid; unit < T * 8 / 2; unit += nb) {
        const int pr = unit * 2 + hb, t = pr >> 3, h = pr & 7;
        const int which = i >> 7, key = i & 127;
        {
            const float* qv = qp + (size_t)t * 2048 + h * 256 + which * 128;
            const float* kv = (which ? p.keys_b : p.keys_a) + ((size_t)h * 128 + key) * 128;
            float s = 0.f;
            for (int d = 0; d < 128; ++d) s += qv[d] * kv[d];
            sc[hb][i] = s;
        }
        __syncthreads();
        {
            const float s = sc[hb][i]; int rank = 0;
            for (int j = 0; j < 128; ++j) { const float o = sc[hb][which * 128 + j]; rank += (o > s || (o == s && j < key)) ? 1 : 0; }
            if (rank < 16) { topv[hb][which][rank] = s; topi[hb][which][rank] = key; }
        }
        __syncthreads();
        const float cs = topv[hb][0][i >> 4] + topv[hb][1][i & 15];
        cand[hb][i] = cs;
        __syncthreads();
        {
            int rank = 0;
            for (int j = 0; j < 256; ++j) { const float o = cand[hb][j]; rank += (o > cs || (o == cs && j < i)) ? 1 : 0; }
            if (rank < 16) { fs[hb][rank] = cs; fi[hb][rank] = topi[hb][0][i >> 4] * 128 + topi[hb][1][i & 15]; }
        }
        __syncthreads();
        if (i < 16) {
            float m = fs[hb][0];
            for (int j = 1; j < 16; ++j) m = fmaxf(m, fs[hb][j]);
            float sum = 0.f;
            for (int j = 0; j < 16; ++j) sum += expf(fs[hb][j] - m);
            gate[(size_t)t * 128 + h * 16 + i] = expf(fs[hb][i] - m) / sum;
            idx[(size_t)t * 128 + h * 16 + i] = fi[hb][i];
        }
        __syncthreads();
    }
}
__device__ void phase_gather(const Params& p, const float* h2, int bid, int nb, unsigned char* smem) {
    const float* x1 = ws_x1(p); const float* mod = ws_mod(p);
    const int* idx = ws_idx(p); const float* gate = ws_gate(p);
    float* wl = (float*)smem;
    int* il = (int*)(smem + 512);
    float* red = (float*)(smem + 1024);
    const int tid = threadIdx.x, lane = tid & 63, wave = tid >> 6;
    for (int t = bid; t < T; t += nb) {
        const int b = t / SEQ;
        float4 hv[4];
#pragma unroll
        for (int j = 0; j < 4; ++j) hv[j] = ((const float4*)(h2 + (size_t)t * D))[j * 64 + lane];
        for (int e = wave * 16; e < wave * 16 + 16; ++e) {
            const int id = idx[(size_t)t * 128 + e];
            const float4* ur = (const float4*)(p.pu + (size_t)id * D);
            float s = 0.f;
#pragma unroll
            for (int j = 0; j < 4; ++j) { const float4 u = ur[j * 64 + lane]; s += u.x * hv[j].x + u.y * hv[j].y + u.z * hv[j].z + u.w * hv[j].w; }
            s = wave_sum(s);
            if (lane == 0) { wl[e] = gate[(size_t)t * 128 + e] * 0.5f * s * (1.f + erff(s * 0.70710678118654752f)); il[e] = id; }
        }
        __syncthreads();
        float y0 = 0.f, y1 = 0.f;
        for (int e = 0; e < 128; ++e) {
            const float2 v = *(const float2*)(p.pv + (size_t)il[e] * D + tid * 2);
            y0 += wl[e] * v.x; y1 += wl[e] * v.y;
        }
        const float2 xv = *(const float2*)(x1 + (size_t)t * D + tid * 2);
        const float2 g2 = *(const float2*)(mod + b * 6 * D + 5 * D + tid * 2);
        const float a0 = xv.x + g2.x * y0, a1 = xv.y + g2.y * y1;
        const float ss = wave_sum(a0 * a0 + a1 * a1);
        if (lane == 0) red[wave] = ss;
        __syncthreads();
        float tot = 0.f;
#pragma unroll
        for (int w = 0; w < 8; ++w) tot += red[w];
        const float r = rsqrtf(tot * (1.f / D) + EPS);
        const float2 gf = *(const float2*)(p.g_final + tid * 2);
        *(float2*)(p.out + (size_t)t * D + tid * 2) = make_float2(a0 * r * gf.x, a1 * r * gf.y);
        __syncthreads();
    }
}

struct EpiStore { float* C; int ldc; __device__ void operator()(int r, int c, float v) const { C[(size_t)r * ldc + c] = v; } };
struct EpiRes { const float* x; const float* mod; float* C; __device__ void operator()(int r, int c, float v) const { const int b = r / SEQ; C[(size_t)r * D + c] = x[(size_t)r * D + c] + mod[b * 6 * D + 2 * D + c] * v; } };

template <int PH>
__device__ __forceinline__ void run_phase(const Params& p, int bid, int nb, unsigned char* smem) {
    if (PH == 0) phase_mod(p, bid, nb);
    if (PH == 1) phase_norm_mod(p, p.x, p.out, 0, D, bid, nb);
    if (PH == 2) gemm_f32(p.out, p.w_in, T, NPROJ, D, bid, nb, smem, EpiStore{ws_proj(p), NPROJ});
    if (PH == 3) { phase_sb(p, p.out, bid, nb); }
    if (PH == 4) { phase_gla(p, p.out, bid, nb, smem); }
    if (PH == 5) gemm_f32(p.out, p.w_out, T, D, D, bid, nb, smem, EpiRes{p.x, ws_mod(p), ws_x1(p)});
    if (PH == 6) phase_norm_mod(p, ws_x1(p), p.out, 3 * D, 4 * D, bid, nb);
    if (PH == 7) gemm_f32(p.out, p.w_pq, T, 2048, D, bid, nb, smem, EpiStore{ws_qp(p), 2048});
    if (PH == 8) phase_topk(p, bid, nb, smem);
    if (PH == 9) phase_gather(p, p.out, bid, nb, smem);
}

template <int PH>
__global__ void __launch_bounds__(NT) k_phase(Params p) {
    __shared__ __attribute__((aligned(16))) unsigned char smem[48 * 1024];
    run_phase<PH>(p, blockIdx.x, gridDim.x, smem);
}

__global__ void __launch_bounds__(NT) k_fused(Params p) {
    __shared__ __attribute__((aligned(16))) unsigned char smem[48 * 1024];
    cg::grid_group grid = cg::this_grid();
    const int bid = blockIdx.x, nb = gridDim.x;
    run_phase<0>(p, bid, nb, smem); grid.sync();
    run_phase<1>(p, bid, nb, smem); grid.sync();
    run_phase<2>(p, bid, nb, smem); grid.sync();
    run_phase<3>(p, bid, nb, smem);
    run_phase<4>(p, bid, nb, smem); grid.sync();
    run_phase<5>(p, bid, nb, smem); grid.sync();
    run_phase<6>(p, bid, nb, smem); grid.sync();
    run_phase<7>(p, bid, nb, smem); grid.sync();
    run_phase<8>(p, bid, nb, smem); grid.sync();
    run_phase<9>(p, bid, nb, smem);
}

extern "C" void kernel_launch(void* const* d_in, const int* in_sizes, int n_in, void* d_out, int out_size, void* d_ws, size_t ws_size, hipStream_t stream) {
    Params p{};
    p.x = (const float*)d_in[0]; p.c = (const float*)d_in[1]; p.w_ada = (const float*)d_in[2]; p.b_ada = (const float*)d_in[3];
    p.w_in = (const float*)d_in[4]; p.w_up = (const float*)d_in[5]; p.b_gate = (const float*)d_in[6]; p.g_sb = (const float*)d_in[7];
    p.g_gla = (const float*)d_in[8]; p.w_out = (const float*)d_in[9]; p.w_pq = (const float*)d_in[10]; p.keys_a = (const float*)d_in[11];
    p.keys_b = (const float*)d_in[12]; p.pu = (const float*)d_in[13]; p.pv = (const float*)d_in[14]; p.g_final = (const float*)d_in[15];
    p.out = (float*)d_out; p.ws = (unsigned char*)d_ws;
#if FUSED
    static int grid_blocks = 0;
    if (!grid_blocks) {
        int dev = 0, cus = 0, per_cu = 0;
        hipGetDevice(&dev);
        hipDeviceGetAttribute(&cus, hipDeviceAttributeMultiprocessorCount, dev);
        hipOccupancyMaxActiveBlocksPerMultiprocessor(&per_cu, k_fused, NT, 0);
        if (per_cu > 2) per_cu = 2;
        grid_blocks = cus * per_cu;
    }
    void* args[] = {&p};
    hipError_t e = hipLaunchCooperativeKernel((void*)k_fused, dim3(grid_blocks), dim3(NT), args, 0, stream);
    if (e != hipSuccess) fprintf(stderr, "cooperative launch failed: %s (grid %d)\n", hipGetErrorString(e), grid_blocks);
#else
    const int G = 1024;
    k_phase<0><<<12, NT, 0, stream>>>(p);
    k_phase<1><<<G, NT, 0, stream>>>(p);
    k_phase<2><<<2048, NT, 0, stream>>>(p);
    k_phase<3><<<256, NT, 0, stream>>>(p);
    k_phase<4><<<8, NT, 0, stream>>>(p);
    k_phase<5><<<2048, NT, 0, stream>>>(p);
    k_phase<6><<<G, NT, 0, stream>>>(p);
    k_phase<7><<<2048, NT, 0, stream>>>(p);
    k_phase<8><<<2048, NT, 0, stream>>>(p);
    k_phase<9><<<2048, NT, 0, stream>>>(p);
#endif
}
```

```cpp
#include <hip/hip_runtime.h>
#include <cstdio>
#include <cstdint>
namespace pg8 {
#define PG8_LAS __attribute__((address_space(3)))
typedef unsigned short bf16_t;
typedef short bf16x8 __attribute__((ext_vector_type(8)));
typedef float f32x4 __attribute__((ext_vector_type(4)));
typedef unsigned u32x4 __attribute__((ext_vector_type(4)));
constexpr int BM = 256, BK = 64, HALF = 128, HTB = HALF * BK * 2  , STAGE_BYTES = 8 * HTB, NXCD = 8, WGM = 8;

__host__ __device__ __forceinline__ int lds_byte(int r, int c) { const int st = (r >> 4) * 2 + (c >> 5), rr = r & 15, cc = c & 31, ob = rr * 64 + cc * 2; return st * 1024 + (ob ^ (((ob >> 9) & 1) << 5)); }
__host__ __device__ __forceinline__ void stage_rc(int b, int& R, int& C) { const int st = b / 1024, sb = b % 1024, swz = sb ^ (((sb >> 9) & 1) << 5); R = (st >> 1) * 16 + swz / 64; C = (st & 1) * 32 + (swz % 64) / 2; }
__host__ __device__ __forceinline__ int perm32(int rho) { const int n = rho >> 4, i = rho & 15; return 8 * (i >> 2) + 4 * n + (i & 3); }

struct Unit { int pm, pn; };
struct Gemm { const bf16_t* A; const bf16_t* Bt; int M, N, K; };

struct StaticOrder {
    int nM, nN, nwg, G, c;
    __host__ __device__ void init(int M, int N, int G_, int c_) { nM = M / BM; nN = N / BM; nwg = nM * nN; G = G_; c = c_; }
    __host__ __device__ bool next(int i, Unit& u) const {
        const long L = (long)i * G + c; if (L >= nwg) return false;
        int wgid = (int)L; { const int q = nwg / NXCD, r = nwg % NXCD, xcd = wgid % NXCD, off = wgid / NXCD; wgid = (xcd < r ? xcd * (q + 1) : r * (q + 1) + (xcd - r) * q) + off; }
        const int nig = WGM * nN, gid = wgid / nig, fm = gid * WGM, gsz = (nM - fm) < WGM ? (nM - fm) : WGM;
        u.pm = fm + ((wgid % nig) % gsz); u.pn = (wgid % nig) / gsz; return true;
    }
    __device__ __forceinline__ void a_ready(const Unit&) const {}
    __device__ __forceinline__ void done(const Unit&) const {}
};

__device__ __forceinline__ unsigned cvt_pk_bf16(float lo, float hi) { unsigned r; asm volatile("v_cvt_pk_bf16_f32 %0, %1, %2" : "=v"(r) : "v"(lo), "v"(hi)); return r; }
struct EpiStoreBf16 {
    static constexpr bool PERM = true, AFTER_DRAIN = false;
    bf16_t* O; int ldc;
    __device__ __forceinline__ void operator()(const f32x4 (&acc)[2][2][4][2], const Unit& u, int wr, int wc, int fr, int fq) const {
        const int row0 = u.pm * BM + wr * 64 + fr, col0 = u.pn * BM + wc * 32 + 8 * fq;
#pragma unroll
        for (int ai = 0; ai < 2; ++ai)
#pragma unroll
            for (int m = 0; m < 4; ++m) { bf16_t* rowp = O + (size_t)(row0 + ai * HALF + m * 16) * ldc + col0;
#pragma unroll
                for (int bj = 0; bj < 2; ++bj) { const f32x4 v0 = acc[ai][bj][m][0], v1 = acc[ai][bj][m][1];
                    u32x4 w; w.x = cvt_pk_bf16(v0[0], v0[1]); w.y = cvt_pk_bf16(v0[2], v0[3]); w.z = cvt_pk_bf16(v1[0], v1[1]); w.w = cvt_pk_bf16(v1[2], v1[3]);
                    *(u32x4*)(rowp + bj * HALF) = w; } }
    }
};
struct EpiResF32 {
    static constexpr bool PERM = true, AFTER_DRAIN = false;
    const float* x; const float* mod; float* out; int goff;
    __device__ __forceinline__ void operator()(const f32x4 (&acc)[2][2][4][2], const Unit& u, int wr, int wc, int fr, int fq) const {
        const int row0 = u.pm * BM + wr * 64 + fr, col0 = u.pn * BM + wc * 32 + 8 * fq;
        const float* g = mod + (u.pm >> 5) * 6144 + goff + col0;
        f32x4 gv[2][2];
#pragma unroll
        for (int bj = 0; bj < 2; ++bj)
#pragma unroll
            for (int n = 0; n < 2; ++n) gv[bj][n] = *(const f32x4*)(g + bj * HALF + 4 * n);
#pragma unroll
        for (int ai = 0; ai < 2; ++ai)
#pragma unroll
            for (int m = 0; m < 4; ++m) { const size_t ro = (size_t)(row0 + ai * HALF + m * 16) * 1024 + col0;
#pragma unroll
                for (int bj = 0; bj < 2; ++bj)
#pragma unroll
                    for (int n = 0; n < 2; ++n) { const f32x4 xv = *(const f32x4*)(x + ro + bj * HALF + 4 * n);
                        *(f32x4*)(out + ro + bj * HALF + 4 * n) = xv + gv[bj][n] * acc[ai][bj][m][n]; } }
    }
};
template <class Epi, class Sched, bool ALIGN_EPI = false, bool SP2 = false>
__device__ __forceinline__ void gemm_phase(PG8_LAS unsigned char* lds, const Gemm g, const Sched& S, const Epi& E) {
    const int tid = threadIdx.x, wid = __builtin_amdgcn_readfirstlane(tid >> 6), lane = tid & 63, wr = wid >> 2, wc = wid & 3, fr = lane & 15, fq = lane >> 4;
    const int K = g.K, nt = K / BK;
    unsigned voffA[2], voffB[2];
#pragma unroll
    for (int i = 0; i < 2; ++i) { int R, C; stage_rc(tid * 16 + i * 8192, R, C); const int Rb = Epi::PERM ? ((R & ~31) + perm32(R & 31)) : R;
        voffA[i] = (unsigned)(R * K + C) * 2u; voffB[i] = (unsigned)(Rb * K + C) * 2u; }
    const size_t kstep = (size_t)(BK * 2);
    const size_t hstep = (size_t)HALF * K * 2;
    const size_t tstep = 2 * hstep;
    const unsigned ldsw = (unsigned)wid * 1024u;
    const int aoff = lds_byte(wr * 64 + fr, fq * 8), boff = lds_byte(wc * 32 + fr, fq * 8);
#define PG8_SA(b, h) (((b) * 2 + (h)) * HTB)
#define PG8_SB(b, h) ((4 + (b) * 2 + (h)) * HTB)
#define PG8_STAGE(bufoff, gbase, voff) do { _Pragma("unroll") for (int _i = 0; _i < 2; ++_i) \
        __builtin_amdgcn_global_load_lds((const unsigned*)((const char*)(gbase) + (voff)[_i]), (PG8_LAS unsigned*)(lds + (bufoff) + ldsw + _i * 8192), 16, 0, 0); } while (0)
#define PG8_LDA(dst, b, h) do { _Pragma("unroll") for (int m = 0; m < 4; ++m) _Pragma("unroll") for (int k = 0; k < 2; ++k) dst[m][k] = *(const PG8_LAS bf16x8*)(lds + PG8_SA(b, h) + aoff + m * 2048 + k * 1024); } while (0)
#define PG8_LDB(dst, b, h) do { _Pragma("unroll") for (int n = 0; n < 2; ++n) _Pragma("unroll") for (int k = 0; k < 2; ++k) dst[n][k] = *(const PG8_LAS bf16x8*)(lds + PG8_SB(b, h) + boff + n * 2048 + k * 1024); } while (0)
#define PG8_MMA(ai, bj, At, Bt) do { __builtin_amdgcn_s_setprio(1); _Pragma("unroll") for (int m = 0; m < 4; ++m) _Pragma("unroll") for (int n = 0; n < 2; ++n) _Pragma("unroll") for (int k = 0; k < 2; ++k) \
        acc[ai][bj][m][n] = __builtin_amdgcn_mfma_f32_16x16x32_bf16(Bt[n][k], At[m][k], acc[ai][bj][m][n], 0, 0, 0); __builtin_amdgcn_s_setprio(0); } while (0)
#define PG8_WAIT_V(n) asm volatile("s_waitcnt vmcnt(" #n ")" ::: "memory")
#define PG8_WAIT_L(n) asm volatile("s_waitcnt lgkmcnt(" #n ")" ::: "memory")
#define PG8_BAR __builtin_amdgcn_s_barrier()
#define PG8_SCHED __builtin_amdgcn_sched_barrier(0)
    Unit cur, nxt; int ui = 0;
    if (!S.next(0, cur)) return;
    f32x4 acc[2][2][4][2];
#pragma unroll
    for (int a = 0; a < 2; ++a)
#pragma unroll
        for (int b = 0; b < 2; ++b)
#pragma unroll
            for (int m = 0; m < 4; ++m)
#pragma unroll
                for (int n = 0; n < 2; ++n) acc[a][b][m][n] = (f32x4){0.f, 0.f, 0.f, 0.f};
    bf16x8 At[4][2], B0[2][2], B1[2][2];
    const char* cA = (const char*)g.A + (size_t)cur.pm * tstep; const char* cB = (const char*)g.Bt + (size_t)cur.pn * tstep;
    S.a_ready(cur);
    if constexpr (SP2) {
        PG8_STAGE(PG8_SB(0, 0), cB, voffB); PG8_STAGE(PG8_SB(0, 1), cB + hstep, voffB); PG8_STAGE(PG8_SA(0, 0), cA, voffA); PG8_STAGE(PG8_SA(0, 1), cA + hstep, voffA);
        if (wr == 1) PG8_BAR;
        PG8_WAIT_V(2); PG8_BAR;
        PG8_STAGE(PG8_SB(1, 0), cB + kstep, voffB); PG8_STAGE(PG8_SA(1, 0), cA + kstep, voffA); PG8_STAGE(PG8_SB(1, 1), cB + hstep + kstep, voffB);
        PG8_WAIT_V(6); PG8_BAR;
    } else {
        PG8_STAGE(PG8_SB(0, 0), cB, voffB); PG8_STAGE(PG8_SA(0, 0), cA, voffA); PG8_STAGE(PG8_SB(0, 1), cB + hstep, voffB); PG8_STAGE(PG8_SA(0, 1), cA + hstep, voffA);
        if (wr == 1) PG8_BAR;
        PG8_WAIT_V(4); PG8_BAR;
        PG8_STAGE(PG8_SB(1, 0), cB + kstep, voffB); PG8_STAGE(PG8_SA(1, 0), cA + kstep, voffA); PG8_STAGE(PG8_SB(1, 1), cB + hstep + kstep, voffB);
        PG8_WAIT_V(6); PG8_BAR;
    }
    for (;;) {
        const bool has_next = S.next(ui + 1, nxt);
        const char* nA = has_next ? (const char*)g.A + (size_t)nxt.pm * tstep : cA; const char* nB = has_next ? (const char*)g.Bt + (size_t)nxt.pn * tstep : cB;
        for (int t = 0; t < nt; t += 2) {
            const bool last = (t == nt - 2);
            const char* a1 = cA + (size_t)(t + 1) * kstep;
            const char* a2 = last ? nA : cA + (size_t)(t + 2) * kstep; const char* b2 = last ? nB : cB + (size_t)(t + 2) * kstep;
            const char* a3 = a2 + kstep; const char* b3 = b2 + kstep;
            if (last && has_next) S.a_ready(nxt);
            if constexpr (SP2) {
            PG8_LDB(B0, 0, 0); PG8_LDB(B1, 0, 1); PG8_SCHED; PG8_LDA(At, 0, 0); PG8_STAGE(PG8_SA(1, 1), a1 + hstep, voffA);
            PG8_WAIT_V(8); PG8_WAIT_L(0); PG8_BAR; PG8_MMA(0, 0, At, B0); PG8_MMA(0, 1, At, B1); PG8_BAR; PG8_SCHED;
            PG8_LDA(At, 0, 1); PG8_STAGE(PG8_SB(0, 0), b2, voffB); PG8_STAGE(PG8_SB(0, 1), b2 + hstep, voffB); PG8_STAGE(PG8_SA(0, 0), a2, voffA);
            PG8_WAIT_V(8); PG8_WAIT_L(0); PG8_BAR; PG8_MMA(1, 0, At, B0); PG8_MMA(1, 1, At, B1); PG8_BAR; PG8_SCHED;
            PG8_LDB(B0, 1, 0); PG8_LDB(B1, 1, 1); PG8_SCHED; PG8_LDA(At, 1, 0); PG8_STAGE(PG8_SA(0, 1), a2 + hstep, voffA);
            PG8_WAIT_V(8); PG8_WAIT_L(0); PG8_BAR; PG8_MMA(0, 0, At, B0); PG8_MMA(0, 1, At, B1); PG8_BAR; PG8_SCHED;
            PG8_LDA(At, 1, 1); PG8_STAGE(PG8_SB(1, 0), b3, voffB); PG8_STAGE(PG8_SB(1, 1), b3 + hstep, voffB); PG8_STAGE(PG8_SA(1, 0), a3, voffA);
            PG8_WAIT_V(8); PG8_WAIT_L(0); PG8_BAR; PG8_MMA(1, 0, At, B0); PG8_MMA(1, 1, At, B1); PG8_BAR; PG8_SCHED;
            } else {
            PG8_LDB(B0, 0, 0); PG8_SCHED; PG8_LDA(At, 0, 0); PG8_STAGE(PG8_SA(1, 1), a1 + hstep, voffA);
            PG8_WAIT_L(8); PG8_BAR; PG8_WAIT_L(0); PG8_MMA(0, 0, At, B0); PG8_BAR; PG8_SCHED;
            PG8_LDB(B1, 0, 1); PG8_STAGE(PG8_SB(0, 0), b2, voffB);
            PG8_BAR; PG8_WAIT_L(0); PG8_MMA(0, 1, At, B1); PG8_BAR;
            PG8_LDA(At, 0, 1); PG8_STAGE(PG8_SA(0, 0), a2, voffA);
            PG8_BAR; PG8_WAIT_L(0); PG8_MMA(1, 0, At, B0); PG8_BAR; PG8_SCHED;
            PG8_STAGE(PG8_SB(0, 1), b2 + hstep, voffB);
            PG8_WAIT_V(6); PG8_BAR; PG8_MMA(1, 1, At, B1); PG8_BAR;
            PG8_LDB(B0, 1, 0); PG8_SCHED; PG8_LDA(At, 1, 0); PG8_STAGE(PG8_SA(0, 1), a2 + hstep, voffA);
            PG8_WAIT_L(8); PG8_BAR; PG8_WAIT_L(0); PG8_MMA(0, 0, At, B0); PG8_BAR; PG8_SCHED;
            PG8_LDB(B1, 1, 1); PG8_STAGE(PG8_SB(1, 0), b3, voffB);
            PG8_BAR; PG8_WAIT_L(0); PG8_MMA(0, 1, At, B1); PG8_BAR;
            PG8_LDA(At, 1, 1); PG8_STAGE(PG8_SA(1, 0), a3, voffA);
            PG8_BAR; PG8_WAIT_L(0); PG8_MMA(1, 0, At, B0); PG8_BAR; PG8_SCHED;
            PG8_STAGE(PG8_SB(1, 1), b3 + hstep, voffB);
            PG8_WAIT_V(6); PG8_BAR; PG8_MMA(1, 1, At, B1); PG8_BAR;
            }
        }
        if constexpr (ALIGN_EPI) { if (wr == 0) PG8_BAR; }
        if constexpr (!Epi::AFTER_DRAIN) { E(acc, cur, wr, wc, fr, fq); S.done(cur); }
        if (!has_next) break;
#pragma unroll
        for (int a = 0; a < 2; ++a)
#pragma unroll
            for (int b = 0; b < 2; ++b)
#pragma unroll
                for (int m = 0; m < 4; ++m)
#pragma unroll
                    for (int n = 0; n < 2; ++n) acc[a][b][m][n] = (f32x4){0.f, 0.f, 0.f, 0.f};
        cur = nxt; cA = nA; cB = nB; ++ui;
        if constexpr (ALIGN_EPI) { if (wr == 1) PG8_BAR; }
    }
    PG8_WAIT_V(0);
    if constexpr (!ALIGN_EPI) { if (wr == 0) PG8_BAR; }
    PG8_BAR;
    if constexpr (Epi::AFTER_DRAIN) { E.fused(acc, cur, wr, wc, fr, fq, lds, wid, lane); S.done(cur); }
#undef PG8_SA
#undef PG8_SB
#undef PG8_STAGE
#undef PG8_LDA
#undef PG8_LDB
#undef PG8_MMA
#undef PG8_WAIT_V
#undef PG8_WAIT_L
#undef PG8_BAR
#undef PG8_SCHED
}
}
#define GAS __attribute__((address_space(1)))
#define LAS __attribute__((address_space(3)))
typedef unsigned short bf16;
typedef unsigned v4u __attribute__((ext_vector_type(4)));
typedef float f32x4 __attribute__((ext_vector_type(4)));
typedef short bf16x8 __attribute__((ext_vector_type(8)));
typedef GAS unsigned gu32;
typedef GAS unsigned long long gu64;
#define RLX_AGENT __ATOMIC_RELAXED, __HIP_MEMORY_SCOPE_AGENT
#define LDS_WAIT() asm volatile("s_waitcnt lgkmcnt(0)" ::: "memory")
#define VM_WAIT() asm volatile("s_waitcnt vmcnt(0)" ::: "memory")
__device__ __forceinline__ unsigned long long rt() { return __builtin_amdgcn_s_memrealtime(); }
__device__ __forceinline__ unsigned f2bf(float f) { unsigned u = __builtin_bit_cast(unsigned, f); return (u + 0x7fffu + ((u >> 16) & 1u)) >> 16; }
__device__ __forceinline__ unsigned pk2(float lo, float hi) { return f2bf(lo) | (f2bf(hi) << 16); }

#define XB_TMO      128
#define XB_XCNT(j)  (256  + 64 * (j))
#define XB_XSUB(j)  (1280 + 64 * (j))
#define XB_XGEN(j)  (2304 + 64 * (j))
#define XB_TOP      3328
#define XB_TOPGEN   3392
#define XCD_BAR_WORDS 3456
#define XB_SPIN_CAP (1u << 18)

__device__ __forceinline__ unsigned xb_ld(unsigned* p)              { return __hip_atomic_load(p, __ATOMIC_RELAXED, __HIP_MEMORY_SCOPE_AGENT); }
__device__ __forceinline__ unsigned xb_add(unsigned* p, unsigned v) { return __hip_atomic_fetch_add(p, v, __ATOMIC_RELAXED, __HIP_MEMORY_SCOPE_AGENT); }
__device__ __forceinline__ unsigned xb_xcc_id() { return (unsigned)__builtin_amdgcn_s_getreg((3 << 11) | 20) & 0xFu; }
#define XB_SPIN(cond, bar) do { unsigned _sp = 0; while (cond) { __builtin_amdgcn_s_sleep(1); \
    if ((++_sp & 255u) == 0u) { if (xb_ld(&(bar)[XB_TMO])) break; if (_sp > XB_SPIN_CAP) { atomicAdd(&(bar)[XB_TMO], 1u); break; } } } } while (0)

struct XcdBarrier {
    unsigned* bar; unsigned x;
    volatile LAS unsigned* st;
};

__device__ __forceinline__ XcdBarrier xcd_barrier_post(unsigned* bar, volatile LAS unsigned* st) {
    XcdBarrier b; b.bar = bar; b.x = xb_xcc_id(); b.st = st;
    if (threadIdx.x == 0) (void)xb_add(&bar[XB_XCNT(b.x)], 1u);
    return b;
}
__device__ __forceinline__ void xcd_barrier_complete(unsigned* bar, unsigned x, unsigned& nloc, unsigned& nx) {
    const unsigned G = gridDim.x * gridDim.y * gridDim.z;
    unsigned sum, cnt, mine, sp = 0u;
    for (;;) {
        sum = 0u; cnt = 0u; mine = 0u;
#pragma unroll
        for (unsigned j = 0; j < 16; ++j) { const unsigned c = xb_ld(&bar[XB_XCNT(j)]); sum += c; cnt += (c > 0u) ? 1u : 0u; mine = (j == x) ? c : mine; }
        if (sum == G) break;
        __builtin_amdgcn_s_sleep(1);
        if ((++sp & 255u) == 0u) { if (xb_ld(&bar[XB_TMO])) break; if (sp > XB_SPIN_CAP) { atomicAdd(&bar[XB_TMO], 1u); break; } }
    }
    nloc = mine > 0u ? mine : 1u; nx = cnt > 0u ? cnt : 1u;
}

__device__ __forceinline__ void xcd_barrier(const XcdBarrier& b) {
    asm volatile("s_waitcnt vmcnt(0)" ::: "memory");
    __syncthreads();
    if (threadIdx.x == 0) {
        unsigned* bar = b.bar;
        __builtin_amdgcn_s_waitcnt(0);
        unsigned nloc = b.st[0], nx = b.st[1];
        if (nloc == 0u) { xcd_barrier_complete(bar, b.x, nloc, nx); b.st[0] = nloc; b.st[1] = nx; }
        const unsigned old = xb_add(&bar[XB_XSUB(b.x)], 1u);
        const unsigned gen = old / nloc;
        if (old + 1u == (gen + 1u) * nloc) {
            __builtin_amdgcn_fence(__ATOMIC_RELEASE, "agent");
            asm volatile("s_waitcnt vmcnt(0)" ::: "memory");
            const unsigned og = xb_add(&bar[XB_TOP], 1u);
            const unsigned tg = og / nx;
            if (og + 1u == (tg + 1u) * nx) xb_add(&bar[XB_TOPGEN], 1u);
            else XB_SPIN(xb_ld(&bar[XB_TOPGEN]) == tg, bar);
            __builtin_amdgcn_fence(__ATOMIC_ACQUIRE, "agent");
            xb_add(&bar[XB_XGEN(b.x)], 1u);
            asm volatile("s_waitcnt vmcnt(0)" ::: "memory");
        } else {
            XB_SPIN(xb_ld(&bar[XB_XGEN(b.x)]) == gen, bar);
            __builtin_amdgcn_fence(__ATOMIC_ACQUIRE, "agent");
            asm volatile("s_waitcnt vmcnt(0)" ::: "memory");
        }
    }
    __syncthreads();
}
constexpr int T = 16384, D = 1024, SEQ = 8192, NPROJ = 3088, NPAD = 3328, NWAVES = 8, NTHR = 512;
constexpr int OFF_SBQ = 0, OFF_SBK = 512, OFF_SBV = 1024, OFF_GQ = 1536, OFF_GK = 1792, OFF_GV = 2048, OFF_GLR = 2560, OFF_GR = 2576;
constexpr float EPS = 1e-6f;
constexpr size_t MiB = 1u << 20;
constexpr size_t WS_CTL = 0, CTL_ZERO_BYTES = 64 * 1024, WS_MOD = 256 * 1024;
constexpr size_t WS_XN = 1 * MiB, WS_WI = 33 * MiB, WS_WO = 40 * MiB, WS_WPQ = 42 * MiB, WS_KEYS = 46 * MiB;
constexpr size_t WS_PROJ = 48 * MiB, WS_MIXIN = 152 * MiB, WS_QP = 48 * MiB, WS_IDX = 112 * MiB, WS_GATE = 120 * MiB;
constexpr size_t WS_UQ = 184 * MiB, WS_VQ = 200 * MiB, WS_USC = 216 * MiB, WS_VSC = 216 * MiB + 65536;
constexpr size_t DO_DS = 0, DO_GS = 32 * MiB, DO_SST = 33 * MiB;
constexpr int CW_BAR = 4096;
constexpr int RING_BYTES = 131072, MISC_OFF = RING_BYTES + 320, LDS_BYTES = 147456;

__device__ __forceinline__ float bflo(unsigned w) { return __uint_as_float(w << 16); }
__device__ __forceinline__ float bfhi(unsigned w) { return __uint_as_float(w & 0xffff0000u); }
__device__ __forceinline__ float bf2f(bf16 v) { return __uint_as_float((unsigned)v << 16); }
__device__ __forceinline__ float wave_sum(float v) {
#pragma unroll
    for (int o = 1; o < 64; o <<= 1) v += __shfl_xor(v, o);
    return v;
}
__device__ __forceinline__ float softplusf(float z) { return fmaxf(z, 0.f) + log1pf(expf(-fabsf(z))); }
__device__ __forceinline__ float siluf(float v) { return v / (1.f + expf(-v)); }

struct Args { const float* in[16]; float* out; unsigned char* ws; };
#define IN_X 0
#define IN_C 1
#define IN_WADA 2
#define IN_BADA 3
#define IN_WIN 4
#define IN_WUP 5
#define IN_BGATE 6
#define IN_GSB 7
#define IN_GGLA 8
#define IN_WOUT 9
#define IN_WPQ 10
#define IN_KA 11
#define IN_KB 12
#define IN_PU 13
#define IN_PV 14
#define IN_GF 15

__device__ __forceinline__ void transpose_item(const float* W, int K, int N, int Npad, bf16* WT, LAS float* scr, int item, int lane) {
    const int nblk = Npad / 32, kb = item / nblk, nb = item % nblk, k0 = 64 * kb, n0 = 32 * nb;
    const int n_in = n0 + (lane & 31); const bool ok = n_in < N;
#pragma unroll 8
    for (int i = 0; i < 32; ++i) { const int kk = 2 * i + (lane >> 5); scr[kk * 33 + (lane & 31)] = ok ? W[(size_t)(k0 + kk) * N + n_in] : 0.f; }
    LDS_WAIT(); asm volatile("" ::: "memory");
    const int c = lane & 7;
#pragma unroll
    for (int j = 0; j < 4; ++j) { const int n = (lane >> 3) + 8 * j; const LAS float* s = scr + (8 * c) * 33 + n;
        v4u o; o.x = pk2(s[0 * 33], s[1 * 33]); o.y = pk2(s[2 * 33], s[3 * 33]); o.z = pk2(s[4 * 33], s[5 * 33]); o.w = pk2(s[6 * 33], s[7 * 33]);
        *(GAS v4u*)(WT + (size_t)(n0 + n) * K + k0 + 8 * c) = o; }
    LDS_WAIT(); asm volatile("" ::: "memory");
}
__device__ __forceinline__ void phase_mod(const Args& a, int bid, int nb, unsigned char* lds) {
    float* scr = (float*)lds;
    float* mod = (float*)(a.ws + WS_MOD);
    const float* c = a.in[IN_C]; const float* w_ada = a.in[IN_WADA]; const float* b_ada = a.in[IN_BADA];
    const int tid = threadIdx.x;
    for (int chunk = bid; chunk < 256; chunk += nb) {
        if (tid < 504) {
            const int col = tid % 24, kg = tid / 24, n = chunk * 24 + col; float a0 = 0.f, a1 = 0.f;
            for (int k = kg; k < D; k += 21) { const float w = w_ada[(size_t)k * 6144 + n]; a0 += siluf(c[k]) * w; a1 += siluf(c[D + k]) * w; }
            scr[kg * 48 + col] = a0; scr[kg * 48 + 24 + col] = a1;
        }
        __syncthreads();
        if (tid < 48) { float s = 0.f; for (int kg = 0; kg < 21; ++kg) s += scr[kg * 48 + tid];
            const int b = tid / 24, n = chunk * 24 + tid % 24; mod[b * 6144 + n] = s + b_ada[n]; }
        __syncthreads();
    }
}
__device__ __forceinline__ void norm_row_to_bf16(const float* xrow, bf16* orow, const float* modb, int shift_off, int scale_off, int lane) {
    const f32x4* xr = (const f32x4*)xrow + lane;
    f32x4 v[4]; float ss = 0.f;
#pragma unroll
    for (int j = 0; j < 4; ++j) { v[j] = xr[64 * j]; ss += (v[j].x * v[j].x + v[j].y * v[j].y) + (v[j].z * v[j].z + v[j].w * v[j].w); }
    const float r = rsqrtf(wave_sum(ss) * (1.f / D) + EPS);
    unsigned long long* o8 = (unsigned long long*)orow + lane;
#pragma unroll
    for (int j = 0; j < 4; ++j) {
        const int col = 4 * lane + 256 * j;
        const f32x4 sc = *(const f32x4*)(modb + scale_off + col), sh = *(const f32x4*)(modb + shift_off + col);
        const f32x4 o = v[j] * r * (sc + 1.f) + sh;
        o8[64 * j] = (unsigned long long)pk2(o.x, o.y) | ((unsigned long long)pk2(o.z, o.w) << 32);
    }
}
__device__ __forceinline__ void phase_norm(const Args& a, const float* src, bf16* dst, int shift_off, int scale_off, int bid, int nb) {
    const float* mod = (const float*)(a.ws + WS_MOD);
    const int lane = threadIdx.x & 63, wave = threadIdx.x >> 6;
    for (int row = bid * NWAVES + wave; row < T; row += nb * NWAVES)
        norm_row_to_bf16(src + (size_t)row * D, dst + (size_t)row * D, mod + (row / SEQ) * 6144, shift_off, scale_off, lane);
}

__device__ void phase_sb_simple(const Args& a, int bid, int nb) {
    const bf16* proj = (const bf16*)(a.ws + WS_PROJ); bf16* mixin = (bf16*)(a.ws + WS_MIXIN); const float* g_sb = a.in[IN_GSB];
    for (int g = bid * NTHR + threadIdx.x; g < 2 * 8 * SEQ; g += nb * NTHR) {
        const int t = g % SEQ, h = (g / SEQ) % 8, b = g / (8 * SEQ);
        const size_t tok = (size_t)b * SEQ + t;
        float q[64], o[64];
        const bf16* qr = proj + tok * NPAD + OFF_SBQ + h * 64;
#pragma unroll
        for (int d = 0; d < 64; ++d) { q[d] = bf2f(qr[d]) * 0.125f; o[d] = 0.f; }
        float carry = 0.f;
        for (int s = t - 1; s >= 0; --s) {
            const v4u* kr = (const v4u*)(proj + ((size_t)b * SEQ + s) * NPAD + OFF_SBK + h * 64);
            const v4u* vr = (const v4u*)(proj + ((size_t)b * SEQ + s) * NPAD + OFF_SBV + h * 64);
            float z = 0.f;
#pragma unroll
            for (int i = 0; i < 8; ++i) { const v4u kv = kr[i];
                z += q[8 * i + 0] * bflo(kv.x) + q[8 * i + 1] * bfhi(kv.x) + q[8 * i + 2] * bflo(kv.y) + q[8 * i + 3] * bfhi(kv.y)
                   + q[8 * i + 4] * bflo(kv.z) + q[8 * i + 5] * bfhi(kv.z) + q[8 * i + 6] * bflo(kv.w) + q[8 * i + 7] * bfhi(kv.w); }
            const float lb = -softplusf(-z);
            const float w = expf(lb + carry);
#pragma unroll
            for (int i = 0; i < 8; ++i) { const v4u vv = vr[i];
                o[8 * i + 0] += w * bflo(vv.x); o[8 * i + 1] += w * bfhi(vv.x); o[8 * i + 2] += w * bflo(vv.y); o[8 * i + 3] += w * bfhi(vv.y);
                o[8 * i + 4] += w * bflo(vv.z); o[8 * i + 5] += w * bfhi(vv.z); o[8 * i + 6] += w * bflo(vv.w); o[8 * i + 7] += w * bfhi(vv.w); }
            carry -= softplusf(z);
            if (carry < -104.f) break;
        }
        float ss = 0.f;
#pragma unroll
        for (int d = 0; d < 64; ++d) ss += o[d] * o[d];
        const float r = rsqrtf(ss * (1.f / 64.f) + EPS);
        bf16* orow = mixin + tok * D + h * 64;
#pragma unroll
        for (int d = 0; d < 64; d += 2) *(unsigned*)(orow + d) = pk2(o[d] * r * g_sb[h * 64 + d], o[d + 1] * r * g_sb[h * 64 + d + 1]);
    }
}
__device__ void phase_gla_simple(const Args& a, int bid, int nb, unsigned char* smem) {
    const bf16* proj = (const bf16*)(a.ws + WS_PROJ); bf16* mixin = (bf16*)(a.ws + WS_MIXIN);
    const float* w_up = a.in[IN_WUP]; const float* b_gate = a.in[IN_BGATE]; const float* g_gla = a.in[IN_GGLA];
    float (*a_l)[64] = (float (*)[64])smem;
    float (*k_l)[64] = (float (*)[64])(smem + 4096);
    float (*q_l)[64] = (float (*)[64])(smem + 8192);
    float (*po)[4][128] = (float (*)[4][128])(smem + 12288);
    const int tid = threadIdx.x, dv = tid & 127, dq = tid >> 7, lane = tid & 63, wave = tid >> 6;
    for (int bh = bid; bh < 8; bh += nb) {
        const int b = bh >> 2, h = bh & 3;
        float s[16];
#pragma unroll
        for (int i = 0; i < 16; ++i) s[i] = 0.f;
        for (int t0 = 0; t0 < SEQ; t0 += 16) {
            for (int idx = tid; idx < 16 * 64; idx += NTHR) {
                const int tt = idx >> 6, d = idx & 63;
                const bf16* pr = proj + ((size_t)b * SEQ + t0 + tt) * NPAD;
                float xg = b_gate[h * 64 + d];
#pragma unroll
                for (int r = 0; r < 16; ++r) xg += bf2f(pr[OFF_GLR + r]) * w_up[r * 256 + h * 64 + d];
                a_l[tt][d] = expf(-softplusf(-xg) * (1.f / 16.f));
                k_l[tt][d] = bf2f(pr[OFF_GK + h * 64 + d]);
                q_l[tt][d] = bf2f(pr[OFF_GQ + h * 64 + d]) * 0.125f;
            }
            __syncthreads();
            for (int tt = 0; tt < 16; ++tt) {
                const float v = bf2f(proj[((size_t)b * SEQ + t0 + tt) * NPAD + OFF_GV + h * 128 + dv]);
                float part = 0.f;
#pragma unroll
                for (int i = 0; i < 16; ++i) { const int d = dq * 16 + i; s[i] = a_l[tt][d] * s[i] + k_l[tt][d] * v; part += q_l[tt][d] * s[i]; }
                po[tt][dq][dv] = part;
            }
            __syncthreads();
            for (int tt = wave; tt < 16; tt += 8) {
                const size_t tok = (size_t)b * SEQ + t0 + tt;
                const float o0 = po[tt][0][lane] + po[tt][1][lane] + po[tt][2][lane] + po[tt][3][lane];
                const float o1 = po[tt][0][lane + 64] + po[tt][1][lane + 64] + po[tt][2][lane + 64] + po[tt][3][lane + 64];
                const float ss = wave_sum(o0 * o0 + o1 * o1);
                const float r = rsqrtf(ss * (1.f / 128.f) + EPS);
                const bf16* gr = proj + tok * NPAD + OFF_GR + h * 128;
                bf16* orow = mixin + tok * D + 512 + h * 128;
                orow[lane] = (bf16)f2bf(o0 * r * g_gla[h * 128 + lane] * siluf(bf2f(gr[lane])));
                orow[lane + 64] = (bf16)f2bf(o1 * r * g_gla[h * 128 + lane + 64] * siluf(bf2f(gr[lane + 64])));
            }
        }
        __syncthreads();
    }
}
__device__ void phase_topk_simple(const Args& a, int bid, int nb, unsigned char* smem) {
    const bf16* qp = (const bf16*)(a.ws + WS_QP);
    int* idx = (int*)(a.ws + WS_IDX); float* gate = (float*)(a.ws + WS_GATE);
    const int tid = threadIdx.x, hb = tid >> 8, i = tid & 255;
    float (*sc)[256] = (float (*)[256])smem;
    float (*topv)[2][16] = (float (*)[2][16])(smem + 2048);
    int (*topi)[2][16] = (int (*)[2][16])(smem + 2048 + 256);
    float (*cand)[256] = (float (*)[256])(smem + 4096);
    float (*fs)[16] = (float (*)[16])(smem + 8192);
    int (*fi)[16] = (int (*)[16])(smem + 8192 + 128);
    for (int unit = bid; unit < T * 8 / 2; unit += nb) {
        const int pr = unit * 2 + hb, t = pr >> 3, h = pr & 7;
        const int which = i >> 7, key = i & 127;
        {
            const bf16* qv = qp + (size_t)t * 2048 + h * 256 + which * 128;
            const float* kv = (which ? a.in[IN_KB] : a.in[IN_KA]) + ((size_t)h * 128 + key) * 128;
            float s = 0.f;
            for (int d = 0; d < 128; ++d) s += bf2f(qv[d]) * kv[d];
            sc[hb][i] = s;
        }
        __syncthreads();
        {
            const float s = sc[hb][i]; int rank = 0;
            for (int j = 0; j < 128; ++j) { const float o = sc[hb][which * 128 + j]; rank += (o > s || (o == s && j < key)) ? 1 : 0; }
            if (rank < 16) { topv[hb][which][rank] = s; topi[hb][which][rank] = key; }
        }
        __syncthreads();
        const float cs = topv[hb][0][i >> 4] + topv[hb][1][i & 15];
        cand[hb][i] = cs;
        __syncthreads();
        {
            int rank = 0;
            for (int j = 0; j < 256; ++j) { const float o = cand[hb][j]; rank += (o > cs || (o == cs && j < i)) ? 1 : 0; }
            if (rank < 16) { fs[hb][rank] = cs; fi[hb][rank] = topi[hb][0][i >> 4] * 128 + topi[hb][1][i & 15]; }
        }
        __syncthreads();
        if (i < 16) {
            float m = fs[hb][0];
            for (int j = 1; j < 16; ++j) m = fmaxf(m, fs[hb][j]);
            float sum = 0.f;
            for (int j = 0; j < 16; ++j) sum += expf(fs[hb][j] - m);
            gate[(size_t)t * 128 + h * 16 + i] = expf(fs[hb][i] - m) / sum;
            idx[(size_t)t * 128 + h * 16 + i] = fi[hb][i];
        }
        __syncthreads();
    }
}
__device__ void phase_gather_simple(const Args& a, int bid, int nb, unsigned char* smem) {
    const bf16* h2 = (const bf16*)(a.ws + WS_XN); const float* mod = (const float*)(a.ws + WS_MOD);
    const int* idx = (const int*)(a.ws + WS_IDX); const float* gate = (const float*)(a.ws + WS_GATE);
    const float* pu = a.in[IN_PU]; const float* pv = a.in[IN_PV]; const float* g_final = a.in[IN_GF];
    float* wl = (float*)smem; int* il = (int*)(smem + 512); float* red = (float*)(smem + 1024);
    const int tid = threadIdx.x, lane = tid & 63, wave = tid >> 6;
    for (int t = bid; t < T; t += nb) {
        const int b = t / SEQ;
        f32x4 hv[4];
#pragma unroll
        for (int j = 0; j < 4; ++j) { const uint2 w = ((const uint2*)(h2 + (size_t)t * D))[j * 64 + lane]; hv[j] = (f32x4){bflo(w.x), bfhi(w.x), bflo(w.y), bfhi(w.y)}; }
        for (int e = wave * 16; e < wave * 16 + 16; ++e) {
            const int id = idx[(size_t)t * 128 + e];
            const f32x4* ur = (const f32x4*)(pu + (size_t)id * D);
            float s = 0.f;
#pragma unroll
            for (int j = 0; j < 4; ++j) { const f32x4 u = ur[j * 64 + lane]; s += u.x * hv[j].x + u.y * hv[j].y + u.z * hv[j].z + u.w * hv[j].w; }
            s = wave_sum(s);
            if (lane == 0) { wl[e] = gate[(size_t)t * 128 + e] * 0.5f * s * (1.f + erff(s * 0.70710678118654752f)); il[e] = id; }
        }
        __syncthreads();
        float y0 = 0.f, y1 = 0.f;
        for (int e = 0; e < 128; ++e) { const float2 v = *(const float2*)(pv + (size_t)il[e] * D + tid * 2); y0 += wl[e] * v.x; y1 += wl[e] * v.y; }
        const float2 xv = *(const float2*)(a.out + (size_t)t * D + tid * 2);
        const float2 g2 = *(const float2*)(mod + b * 6144 + 5 * D + tid * 2);
        const float a0 = xv.x + g2.x * y0, a1 = xv.y + g2.y * y1;
        const float ss = wave_sum(a0 * a0 + a1 * a1);
        if (lane == 0) red[wave] = ss;
        __syncthreads();
        float tot = 0.f;
#pragma unroll
        for (int w = 0; w < 8; ++w) tot += red[w];
        const float r = rsqrtf(tot * (1.f / D) + EPS);
        const float2 gf = *(const float2*)(g_final + tid * 2);
        *(float2*)(a.out + (size_t)t * D + tid * 2) = make_float2(a0 * r * gf.x, a1 * r * gf.y);
        __syncthreads();
    }
}

__device__ __forceinline__ void quant_row(const float* row, unsigned char* q, float* scale_out, int bias, int lane) {
    const f32x4* r4 = (const f32x4*)row + lane * 4;
    f32x4 v[4]; float am = 0.f;
#pragma unroll
    for (int j = 0; j < 4; ++j) { v[j] = r4[j]; am = fmaxf(fmaxf(am, fmaxf(fabsf(v[j].x), fabsf(v[j].y))), fmaxf(fabsf(v[j].z), fabsf(v[j].w))); }
#pragma unroll
    for (int o = 1; o < 64; o <<= 1) am = fmaxf(am, __shfl_xor(am, o));
    const float inv = am > 0.f ? 127.f / am : 0.f;
    v4u w;
#pragma unroll
    for (int j = 0; j < 4; ++j) {
        const int q0 = (int)rintf(v[j].x * inv) + bias, q1 = (int)rintf(v[j].y * inv) + bias, q2 = (int)rintf(v[j].z * inv) + bias, q3 = (int)rintf(v[j].w * inv) + bias;
        w[j] = (unsigned)(q0 & 0xff) | ((unsigned)(q1 & 0xff) << 8) | ((unsigned)(q2 & 0xff) << 16) | ((unsigned)(q3 & 0xff) << 24);
    }
    *(v4u*)(q + lane * 16) = w;
    if (lane == 0) *scale_out = am * (1.f / 127.f);
}
__device__ __forceinline__ void gather_token(const Args& a, int t, int idA, int idB, float gA, float gB, int lane) {
    const bf16* h2 = (const bf16*)(a.ws + WS_XN); const float* mod = (const float*)(a.ws + WS_MOD);
    const unsigned char* uq = a.ws + WS_UQ; const unsigned char* vq = a.ws + WS_VQ;
    const float* usc = (const float*)(a.ws + WS_USC); const float* vsc = (const float*)(a.ws + WS_VSC);
    const float* g_final = a.in[IN_GF];
    const int sel = (lane >> 2) & 15;
    const bool b5 = lane & 32, b4 = lane & 16, b3 = lane & 8, b2 = lane & 4;
    const v4u* hp = (const v4u*)(h2 + (size_t)t * D + lane * 16);
    const v4u h0 = hp[0], h1 = hp[1];
    float hv[16];
#pragma unroll
    for (int j = 0; j < 4; ++j) { hv[2 * j] = bflo(h0[j]); hv[2 * j + 1] = bfhi(h0[j]); hv[8 + 2 * j] = bflo(h1[j]); hv[8 + 2 * j + 1] = bfhi(h1[j]); }
    float am = 0.f;
#pragma unroll
    for (int j = 0; j < 16; ++j) am = fmaxf(am, fabsf(hv[j]));
#pragma unroll
    for (int o = 1; o < 64; o <<= 1) am = fmaxf(am, __shfl_xor(am, o));
    const float hinv = am > 0.f ? 127.f / am : 0.f, hs = am * (1.f / 127.f);
    int hq[4];
#pragma unroll
    for (int j = 0; j < 4; ++j) {
        const int q0 = (int)rintf(hv[4 * j] * hinv), q1 = (int)rintf(hv[4 * j + 1] * hinv), q2 = (int)rintf(hv[4 * j + 2] * hinv), q3 = (int)rintf(hv[4 * j + 3] * hinv);
        hq[j] = (int)((unsigned)(q0 & 0xff) | ((unsigned)(q1 & 0xff) << 8) | ((unsigned)(q2 & 0xff) << 16) | ((unsigned)(q3 & 0xff) << 24));
    }
    const float usA = usc[idA], usB = usc[idB], vsA = vsc[idA], vsB = vsc[idB];
    float wreg[8];
#pragma unroll
    for (int bt = 0; bt < 8; ++bt) {
        v4u ub[16];
#pragma unroll
        for (int j = 0; j < 16; ++j) { const int e = bt * 16 + j; const int id = __builtin_amdgcn_readlane(e < 64 ? idA : idB, e & 63);
            ub[j] = *(const v4u*)(uq + (size_t)id * 1024 + lane * 16); }
        int p[16];
#pragma unroll
        for (int j = 0; j < 16; ++j)
            p[j] = __builtin_amdgcn_sdot4((int)ub[j].x, hq[0], __builtin_amdgcn_sdot4((int)ub[j].y, hq[1], __builtin_amdgcn_sdot4((int)ub[j].z, hq[2], __builtin_amdgcn_sdot4((int)ub[j].w, hq[3], 0, false), false), false), false);
        int r1[8], r2[4], r3[2];
#pragma unroll
        for (int k = 0; k < 8; ++k) r1[k] = (b5 ? p[k + 8] : p[k]) + __shfl_xor(b5 ? p[k] : p[k + 8], 32);
#pragma unroll
        for (int k = 0; k < 4; ++k) r2[k] = (b4 ? r1[k + 4] : r1[k]) + __shfl_xor(b4 ? r1[k] : r1[k + 4], 16);
#pragma unroll
        for (int k = 0; k < 2; ++k) r3[k] = (b3 ? r2[k + 2] : r2[k]) + __shfl_xor(b3 ? r2[k] : r2[k + 2], 8);
        int r4 = (b2 ? r3[1] : r3[0]) + __shfl_xor(b2 ? r3[0] : r3[1], 4);
        r4 += __shfl_xor(r4, 2); r4 += __shfl_xor(r4, 1);
        const int src = (bt * 16 + sel) & 63;
        const float us = __shfl(bt < 4 ? usA : usB, src), vs = __shfl(bt < 4 ? vsA : vsB, src), g = __shfl(bt < 4 ? gA : gB, src);
        const float dot = (float)r4 * hs * us;
        wreg[bt] = g * 0.5f * dot * (1.f + erff(dot * 0.70710678118654752f)) * vs;
    }
    float acc[16]; float sw = 0.f;
#pragma unroll
    for (int k = 0; k < 16; ++k) acc[k] = 0.f;
#pragma unroll
    for (int bt = 0; bt < 8; ++bt) {
        v4u vb[16];
#pragma unroll
        for (int j = 0; j < 16; ++j) { const int e = bt * 16 + j; const int id = __builtin_amdgcn_readlane(e < 64 ? idA : idB, e & 63);
            vb[j] = *(const v4u*)(vq + (size_t)id * 1024 + lane * 16); }
#pragma unroll
        for (int j = 0; j < 16; ++j) {
            const float w = __uint_as_float(__builtin_amdgcn_readlane(__float_as_uint(wreg[bt]), 4 * j));
            sw += w;
#pragma unroll
            for (int q = 0; q < 4; ++q) { const unsigned x = vb[j][q];
                acc[4 * q + 0] = fmaf(w, (float)(x & 0xff), acc[4 * q + 0]); acc[4 * q + 1] = fmaf(w, (float)((x >> 8) & 0xff), acc[4 * q + 1]);
                acc[4 * q + 2] = fmaf(w, (float)((x >> 16) & 0xff), acc[4 * q + 2]); acc[4 * q + 3] = fmaf(w, (float)(x >> 24), acc[4 * q + 3]); }
        }
    }
    const int b = t / SEQ;
    f32x4* xo = (f32x4*)(a.out + (size_t)t * D) + lane * 4;
    const f32x4* g2 = (const f32x4*)(mod + b * 6144 + 5 * D) + lane * 4;
    const f32x4* gf = (const f32x4*)g_final + lane * 4;
    f32x4 x2[4]; float ss = 0.f;
#pragma unroll
    for (int q = 0; q < 4; ++q) {
        const f32x4 y = (f32x4){acc[4 * q] - 128.f * sw, acc[4 * q + 1] - 128.f * sw, acc[4 * q + 2] - 128.f * sw, acc[4 * q + 3] - 128.f * sw};
        x2[q] = xo[q] + g2[q] * y;
        ss += (x2[q].x * x2[q].x + x2[q].y * x2[q].y) + (x2[q].z * x2[q].z + x2[q].w * x2[q].w);
    }
    const float r = rsqrtf(wave_sum(ss) * (1.f / D) + EPS);
#pragma unroll
    for (int q = 0; q < 4; ++q) xo[q] = x2[q] * r * gf[q];
}

typedef float f32x16 __attribute__((ext_vector_type(16)));
typedef short bfx8 __attribute__((ext_vector_type(8)));
__device__ __forceinline__ unsigned f2ord(float f) { const unsigned u = __float_as_uint(f); return (u & 0x80000000u) ? ~u : (u | 0x80000000u); }
__device__ __forceinline__ float ord2f(unsigned o) { const unsigned u = (o & 0x80000000u) ? (o & 0x7fffffffu) : ~o; return __uint_as_float(u); }
__device__ __forceinline__ unsigned umax_(unsigned x, unsigned y) { return x > y ? x : y; }
__device__ __forceinline__ unsigned umin_(unsigned x, unsigned y) { return x < y ? x : y; }
template <int N> __device__ __forceinline__ void sort_desc(unsigned (&v)[N]) {
#pragma unroll
    for (int k = 2; k <= N; k <<= 1)
#pragma unroll
        for (int j = k >> 1; j > 0; j >>= 1)
#pragma unroll
            for (int i = 0; i < N; ++i) { const int l = i ^ j; if (l > i) { const bool desc = ((i & k) == 0); const unsigned hi = umax_(v[i], v[l]), lo = umin_(v[i], v[l]); v[i] = desc ? hi : lo; v[l] = desc ? lo : hi; } }
}
__device__ __forceinline__ void merge_top16(unsigned (&x)[16], const unsigned (&y)[16]) {
#pragma unroll
    for (int i = 0; i < 16; ++i) x[i] = umax_(x[i], y[15 - i]);
#pragma unroll
    for (int j = 8; j > 0; j >>= 1)
#pragma unroll
        for (int i = 0; i < 16; ++i) { const int l = i ^ j; if (l > i) { const unsigned hi = umax_(x[i], x[l]), lo = umin_(x[i], x[l]); x[i] = hi; x[l] = lo; } }
}
__device__ __forceinline__ bfx8 bload16(__amdgpu_buffer_rsrc_t r, unsigned voff, unsigned soff) { return __builtin_bit_cast(bfx8, __builtin_amdgcn_raw_buffer_load_b128(r, voff, soff, 0)); }
__device__ __forceinline__ void peer_level1(__amdgpu_buffer_rsrc_t qr, unsigned qoff, __amdgpu_buffer_rsrc_t kr, unsigned koff, unsigned ksoff, int hp, unsigned (&out)[16]) {
    f32x16 acc[4];
#pragma unroll
    for (int kt = 0; kt < 4; ++kt)
#pragma unroll
        for (int r = 0; r < 16; ++r) acc[kt][r] = 0.f;
#pragma unroll
    for (int s = 0; s < 8; ++s) {
        const bfx8 bq = bload16(qr, qoff + 32 * s, 0);
#pragma unroll
        for (int kt = 0; kt < 4; ++kt) { const bfx8 ak = bload16(kr, koff + 32 * s, ksoff + kt * 8192);
            acc[kt] = __builtin_amdgcn_mfma_f32_32x32x16_bf16(ak, bq, acc[kt], 0, 0, 0); }
    }
    unsigned g0[16], g1[16], g2[16], g3[16];
#pragma unroll
    for (int r = 0; r < 16; ++r) {
        const unsigned kb = (unsigned)(127 - ((r & 3) + 8 * (r >> 2) + 4 * hp));
        g0[r] = (f2ord(acc[0][r]) & ~0x7Fu) | kb; g1[r] = (f2ord(acc[1][r]) & ~0x7Fu) | (kb - 32u); g2[r] = (f2ord(acc[2][r]) & ~0x7Fu) | (kb - 64u); g3[r] = (f2ord(acc[3][r]) & ~0x7Fu) | (kb - 96u);
    }
    sort_desc<16>(g0); sort_desc<16>(g1); sort_desc<16>(g2); sort_desc<16>(g3);
    merge_top16(g0, g1); merge_top16(g2, g3); merge_top16(g0, g2);
    unsigned oth[16];
#pragma unroll
    for (int i = 0; i < 16; ++i) oth[i] = __shfl_xor(g0[i], 32);
    merge_top16(g0, oth);
#pragma unroll
    for (int i = 0; i < 16; ++i) out[i] = g0[i];
}
constexpr int TAB_OFF = 0, EID_OFF = 32768, GT_OFF = 49152;
__device__ void phase_peer(const Args& a, int bid, int nb, unsigned char* lds) {
    const bf16* qp = (const bf16*)(a.ws + WS_QP); const bf16* keys = (const bf16*)(a.ws + WS_KEYS);
    const int tid = threadIdx.x, lane = tid & 63, wave = tid >> 6, c31 = lane & 31, hp = lane >> 5;
    unsigned* TAB = (unsigned*)(lds + TAB_OFF) + wave * 1024; int* EID = (int*)(lds + EID_OFF); float* GT = (float*)(lds + GT_OFF);
    const __amdgpu_buffer_rsrc_t qrs = __builtin_amdgcn_make_buffer_rsrc((void*)qp, (short)0, T * 2048 * 2, 0x00020000);
    const __amdgpu_buffer_rsrc_t krs = __builtin_amdgcn_make_buffer_rsrc((void*)keys, (short)0, 2 * 8 * 128 * 128 * 2, 0x00020000);
    for (int task = bid; task < T / 32; task += nb) {
        const int tok0 = task * 32, h = wave;
        unsigned top0[16], top1[16];
        {
            const unsigned qoff = (unsigned)(tok0 + c31) * 4096u + (unsigned)h * 512u + (unsigned)hp * 16u, koff = (unsigned)c31 * 256u + (unsigned)hp * 16u;
            const unsigned ks0 = (unsigned)__builtin_amdgcn_readfirstlane(h) * 32768u;
            peer_level1(qrs, qoff, krs, koff, ks0, hp, top0);
            peer_level1(qrs, qoff + 256u, krs, koff, ks0 + 262144u, hp, top1);
        }
#pragma unroll
        for (int i = 0; i < 16; ++i) TAB[i * 64 + lane] = (127u - (top0[i] & 0x7Fu)) | ((127u - (top1[i] & 0x7Fu)) << 8);
        float fa[16], fb[16];
#pragma unroll
        for (int i = 0; i < 16; ++i) { const unsigned x = hp ? top1[i] : top0[i], y = hp ? top0[i] : top1[i]; fa[i] = ord2f(x & ~0x7Fu); fb[i] = ord2f(y & ~0x7Fu); }
        unsigned c0[16], c1[16];
#pragma unroll
        for (int j = 0; j < 16; ++j) { const unsigned code = hp ? (unsigned)((j << 4) | 0) : (unsigned)j; c0[j] = (f2ord(fa[0] + fb[j]) & ~0xFFu) | code; }
        if (hp) c0[0] = 0u;
        {
            constexpr int CI[11] = {1, 1, 1, 1, 1, 1, 1, 2, 2, 2, 3}, CJ[11] = {1, 2, 3, 4, 5, 6, 7, 2, 3, 4, 3};
#pragma unroll
            for (int m = 0; m < 11; ++m) {
                const int i = CI[m], j = CJ[m];
                const unsigned code = hp ? (unsigned)((j << 4) | i) : (unsigned)((i << 4) | j);
                unsigned key = (f2ord(fa[i] + fb[j]) & ~0xFFu) | code;
                if (i == j && hp) key = 0u;
                c1[m] = key;
            }
#pragma unroll
            for (int m = 11; m < 16; ++m) c1[m] = 0u;
        }
        sort_desc<16>(c0); sort_desc<16>(c1); merge_top16(c0, c1);
        {
            unsigned oth[16];
#pragma unroll
            for (int i = 0; i < 16; ++i) oth[i] = __shfl_xor(c0[i], 32);
            merge_top16(c0, oth);
        }
        const float smax = ord2f(c0[0] & ~0xFFu);
        float ex[16], esum = 0.f;
#pragma unroll
        for (int i = 0; i < 16; ++i) { ex[i] = __expf(ord2f(c0[i] & ~0xFFu) - smax); esum += ex[i]; }
        const float rinv = 1.f / esum;
        const unsigned hmask = 0u - (unsigned)hp;
#pragma unroll
        for (int m = 0; m < 8; ++m) {
            const unsigned code = ((c0[8 + m] & hmask) | (c0[m] & ~hmask)) & 0xFFu; const float gv = __uint_as_float((__float_as_uint(ex[8 + m]) & hmask) | (__float_as_uint(ex[m]) & ~hmask)) * rinv;
            const unsigned k1 = TAB[(code >> 4) * 64 + lane] & 0xFFu, k2 = (TAB[(code & 15u) * 64 + lane] >> 8) & 0xFFu;
            EID[c31 * 128 + h * 16 + 8 * hp + m] = (int)(k1 * 128u + k2);
            GT[c31 * 128 + h * 16 + 8 * hp + m] = gv;
        }
        __syncthreads();
        for (int i = 0; i < 4; ++i) {
            const int tt = wave * 4 + i;
            gather_token(a, tok0 + tt, EID[tt * 128 + lane], EID[tt * 128 + 64 + lane], GT[tt * 128 + lane], GT[tt * 128 + 64 + lane], lane);
        }
        __syncthreads();
    }
}

typedef float f32x4_t __attribute__((ext_vector_type(4)));
typedef short s16x8 __attribute__((ext_vector_type(8)));
constexpr int BCS = 68, KS = 72;
constexpr int GL_OFF = 0, BC_OFF = 4096, TOT_OFF = BC_OFF + 64 * BCS * 4, KDT_OFF = TOT_OFF + 2048, VT_OFF = KDT_OFF + 64 * KS * 2, PL_OFF = VT_OFF + 128 * KS * 2, RS_OFF = PL_OFF + 64 * KS * 2;
static_assert(RS_OFF + 1024 <= RING_BYTES, "GLA LDS map");
__device__ __forceinline__ unsigned pkbf(float lo, float hi) { typedef float f2 __attribute__((ext_vector_type(2))); typedef __bf16 b2 __attribute__((ext_vector_type(2))); f2 v = {lo, hi}; b2 b = __builtin_convertvector(v, b2); return __builtin_bit_cast(unsigned, b); }
__device__ __forceinline__ void gla_gating(const Args& a, const bf16* proj, size_t tok0, int h, unsigned char* lds) {
    float* GL = (float*)(lds + GL_OFF); float* BC = (float*)(lds + BC_OFF); float* TOT = (float*)(lds + TOT_OFF);
    const int tid = threadIdx.x, d = tid & 63, tq = tid >> 6;
    for (int i = tid; i < 64 * 16; i += NTHR) GL[i] = bf2f(proj[(tok0 + (i >> 4)) * NPAD + OFF_GLR + (i & 15)]);
    float wu[16];
#pragma unroll
    for (int r = 0; r < 16; ++r) wu[r] = a.in[IN_WUP][r * 256 + h * 64 + d];
    const float bg = a.in[IN_BGATE][h * 64 + d];
    __syncthreads();
    float cum = 0.f;
#pragma unroll
    for (int i = 0; i < 8; ++i) {
        const int t = 8 * tq + i; float x = bg;
#pragma unroll
        for (int r = 0; r < 16; ++r) x += GL[t * 16 + r] * wu[r];
        cum += -softplusf(-x) * (1.f / 16.f);
        BC[t * BCS + d] = cum;
    }
    TOT[tq * 64 + d] = cum;
    __syncthreads();
    float off = 0.f;
    for (int g = 0; g < tq; ++g) off += TOT[g * 64 + d];
#pragma unroll
    for (int i = 0; i < 8; ++i) BC[(8 * tq + i) * BCS + d] += off;
    __syncthreads();
}
__device__ __forceinline__ void gla_stage_vt(const bf16* proj, size_t tok0, int h, unsigned char* lds) {
    bf16* VT = (bf16*)(lds + VT_OFF);
    const int tid = threadIdx.x, s = tid >> 3, dv0 = (tid & 7) * 16;
    const v4u* vp = (const v4u*)(proj + (tok0 + s) * NPAD + OFF_GV + h * 128 + dv0);
    const v4u v0 = vp[0], v1 = vp[1];
#pragma unroll
    for (int j = 0; j < 4; ++j) { VT[(dv0 + 2 * j) * KS + s] = (bf16)(v0[j] & 0xffffu); VT[(dv0 + 2 * j + 1) * KS + s] = (bf16)(v0[j] >> 16);
                                  VT[(dv0 + 8 + 2 * j) * KS + s] = (bf16)(v1[j] & 0xffffu); VT[(dv0 + 8 + 2 * j + 1) * KS + s] = (bf16)(v1[j] >> 16); }
}
__device__ void phase_gla_local(const Args& a, int bid, int nb, unsigned char* lds) {
    const bf16* proj = (const bf16*)(a.ws + WS_PROJ);
    float* DS = (float*)((unsigned char*)a.out + DO_DS); float* GS = (float*)((unsigned char*)a.out + DO_GS);
    const float* BC = (const float*)(lds + BC_OFF); bf16* KDT = (bf16*)(lds + KDT_OFF); const bf16* VT = (const bf16*)(lds + VT_OFF);
    const int tid = threadIdx.x, lane = tid & 63, wave = tid >> 6, fr = lane & 15, fq = lane >> 4;
    for (int u = bid; u < 1024; u += nb) {
        const int h = u & 3, bc = u >> 2; const size_t tok0 = (size_t)bc * 64;
        gla_gating(a, proj, tok0, h, lds);
        {
            const int s = tid >> 3, d0 = (tid & 7) * 8;
            const v4u kv = *(const v4u*)(proj + (tok0 + s) * NPAD + OFF_GK + h * 64 + d0);
#pragma unroll
            for (int j = 0; j < 4; ++j) {
                const float e0 = __expf(BC[63 * BCS + d0 + 2 * j] - BC[s * BCS + d0 + 2 * j]), e1 = __expf(BC[63 * BCS + d0 + 2 * j + 1] - BC[s * BCS + d0 + 2 * j + 1]);
                KDT[(d0 + 2 * j) * KS + s] = (bf16)f2bf(bflo(kv[j]) * e0); KDT[(d0 + 2 * j + 1) * KS + s] = (bf16)f2bf(bfhi(kv[j]) * e1);
            }
        }
        gla_stage_vt(proj, tok0, h, lds);
        if (tid < 64) GS[(size_t)u * 64 + tid] = __expf(BC[63 * BCS + tid]);
        __syncthreads();
        {
            f32x4_t acc[4];
#pragma unroll
            for (int mt = 0; mt < 4; ++mt) acc[mt] = (f32x4_t){0.f, 0.f, 0.f, 0.f};
#pragma unroll
            for (int ks = 0; ks < 2; ++ks) {
                const s16x8 bfrag = *(const s16x8*)(VT + (16 * wave + fr) * KS + 32 * ks + 8 * fq);
#pragma unroll
                for (int mt = 0; mt < 4; ++mt) { const s16x8 afrag = *(const s16x8*)(KDT + (16 * mt + fr) * KS + 32 * ks + 8 * fq);
                    acc[mt] = __builtin_amdgcn_mfma_f32_16x16x32_bf16(afrag, bfrag, acc[mt], 0, 0, 0); }
            }
            float* dst = DS + ((size_t)u * 128 + 16 * wave + fr) * 64 + 4 * fq;
#pragma unroll
            for (int mt = 0; mt < 4; ++mt) *(f32x4_t*)(dst + 16 * mt) = acc[mt];
        }
        __syncthreads();
    }
}
__device__ void phase_gla_scan(const Args& a, int bid, int nb) {
    const float* DS = (const float*)((unsigned char*)a.out + DO_DS); const float* GS = (const float*)((unsigned char*)a.out + DO_GS);
    bf16* SST = (bf16*)((unsigned char*)a.out + DO_SST);
    for (int e = bid * NTHR + threadIdx.x; e < 8 * 8192; e += nb * NTHR) {
        const int bh = e >> 13, el = e & 8191, dk = el & 63, b = bh >> 2, h = bh & 3;
        float S = 0.f;
#pragma unroll 8
        for (int c = 0; c < 128; ++c) {
            const size_t u = (size_t)(b * 128 + c) * 4 + h;
            SST[u * 8192 + el] = (bf16)f2bf(S);
            S = S * GS[u * 64 + dk] + DS[u * 8192 + el];
        }
    }
}
__device__ void phase_gla_out(const Args& a, int bid, int nb, unsigned char* lds) {
    const bf16* proj = (const bf16*)(a.ws + WS_PROJ); bf16* mixin = (bf16*)(a.ws + WS_MIXIN);
    const bf16* SST = (const bf16*)((unsigned char*)a.out + DO_SST); const float* g_gla = a.in[IN_GGLA];
    const float* BC = (const float*)(lds + BC_OFF); const bf16* VT = (const bf16*)(lds + VT_OFF); bf16* PL = (bf16*)(lds + PL_OFF); float* RS = (float*)(lds + RS_OFF);
    const int tid = threadIdx.x, lane = tid & 63, wave = tid >> 6, fr = lane & 15, fq = lane >> 4;
    const int nt = wave & 3, wh = wave >> 2;
    for (int u = bid; u < 1024; u += nb) {
        const int h = u & 3, bc = u >> 2; const size_t tok0 = (size_t)bc * 64;
        gla_gating(a, proj, tok0, h, lds);
        gla_stage_vt(proj, tok0, h, lds);
        s16x8 qi[2], qo[2];
        {
            const int t = 16 * nt + fr;
#pragma unroll
            for (int ks = 0; ks < 2; ++ks) {
                const int d0 = 32 * ks + 8 * fq;
                const v4u qv = *(const v4u*)(proj + (tok0 + t) * NPAD + OFF_GQ + h * 64 + d0);
                v4u wi, wo;
#pragma unroll
                for (int j = 0; j < 4; ++j) {
                    const float b0 = BC[t * BCS + d0 + 2 * j], b1 = BC[t * BCS + d0 + 2 * j + 1], r0 = BC[31 * BCS + d0 + 2 * j], r1 = BC[31 * BCS + d0 + 2 * j + 1];
                    const float q0 = bflo(qv[j]) * 0.125f, q1 = bfhi(qv[j]) * 0.125f;
                    wi[j] = pkbf(q0 * __expf(b0 - r0), q1 * __expf(b1 - r1)); wo[j] = pkbf(q0 * __expf(b0), q1 * __expf(b1));
                }
                qi[ks] = __builtin_bit_cast(s16x8, wi); qo[ks] = __builtin_bit_cast(s16x8, wo);
            }
        }
#pragma unroll
        for (int mi = 0; mi < 2; ++mi) {
            const int ms = wh + 2 * mi, s = 16 * ms + fr;
            f32x4_t acc = (f32x4_t){0.f, 0.f, 0.f, 0.f};
#pragma unroll
            for (int ks = 0; ks < 2; ++ks) {
                const int d0 = 32 * ks + 8 * fq;
                const v4u kv = *(const v4u*)(proj + (tok0 + s) * NPAD + OFF_GK + h * 64 + d0);
                v4u wk;
#pragma unroll
                for (int j = 0; j < 4; ++j) {
                    const float e0 = __expf(BC[31 * BCS + d0 + 2 * j] - BC[s * BCS + d0 + 2 * j]), e1 = __expf(BC[31 * BCS + d0 + 2 * j + 1] - BC[s * BCS + d0 + 2 * j + 1]);
                    wk[j] = pkbf(bflo(kv[j]) * e0, bfhi(kv[j]) * e1);
                }
                acc = __builtin_amdgcn_mfma_f32_16x16x32_bf16(__builtin_bit_cast(s16x8, wk), qi[ks], acc, 0, 0, 0);
            }
            const int t = 16 * nt + fr, s0 = 16 * ms + 4 * fq;
            const float p0 = (s0 + 0 <= t) ? acc[0] : 0.f, p1 = (s0 + 1 <= t) ? acc[1] : 0.f, p2 = (s0 + 2 <= t) ? acc[2] : 0.f, p3 = (s0 + 3 <= t) ? acc[3] : 0.f;
            *(uint2*)(PL + t * KS + s0) = make_uint2(pkbf(p0, p1), pkbf(p2, p3));
        }
        __syncthreads();
        f32x4_t o[4];
#pragma unroll
        for (int i = 0; i < 4; ++i) o[i] = (f32x4_t){0.f, 0.f, 0.f, 0.f};
#pragma unroll
        for (int ks = 0; ks < 2; ++ks) {
            const s16x8 pfrag = *(const s16x8*)(PL + (16 * nt + fr) * KS + 32 * ks + 8 * fq);
#pragma unroll
            for (int i = 0; i < 4; ++i) {
                const int dv = 16 * (4 * wh + i) + fr;
                const s16x8 vfrag = *(const s16x8*)(VT + dv * KS + 32 * ks + 8 * fq);
                const s16x8 sfrag = *(const s16x8*)(SST + (size_t)u * 8192 + dv * 64 + 32 * ks + 8 * fq);
                o[i] = __builtin_amdgcn_mfma_f32_16x16x32_bf16(vfrag, pfrag, o[i], 0, 0, 0);
                o[i] = __builtin_amdgcn_mfma_f32_16x16x32_bf16(sfrag, qo[ks], o[i], 0, 0, 0);
            }
        }
        float ss = 0.f;
#pragma unroll
        for (int i = 0; i < 4; ++i) ss += (o[i][0] * o[i][0] + o[i][1] * o[i][1]) + (o[i][2] * o[i][2] + o[i][3] * o[i][3]);
        ss += __shfl_xor(ss, 16); ss += __shfl_xor(ss, 32);
        if (fq == 0) RS[wh * 64 + 16 * nt + fr] = ss;
        __syncthreads();
        {
            const int t = 16 * nt + fr;
            const float r = rsqrtf((RS[t] + RS[64 + t]) * (1.f / 128.f) + EPS);
            const bf16* gr = proj + (tok0 + t) * NPAD + OFF_GR + h * 128;
            bf16* orow = mixin + (tok0 + t) * D + 512 + h * 128;
#pragma unroll
            for (int i = 0; i < 4; ++i) {
                const int dv = 16 * (4 * wh + i) + 4 * fq;
                const uint2 gw = *(const uint2*)(gr + dv);
                const f32x4_t gg = *(const f32x4_t*)(g_gla + h * 128 + dv);
                const float v0 = o[i][0] * r * gg[0] * siluf(bflo(gw.x)), v1 = o[i][1] * r * gg[1] * siluf(bfhi(gw.x));
                const float v2 = o[i][2] * r * gg[2] * siluf(bflo(gw.y)), v3 = o[i][3] * r * gg[3] * siluf(bfhi(gw.y));
                *(uint2*)(orow + dv) = make_uint2(pkbf(v0, v1), pkbf(v2, v3));
            }
        }
        __syncthreads();
    }
}

__global__ void __launch_bounds__(NTHR, 2) fwd_megakernel(Args a) {
    extern __shared__ __attribute__((aligned(16))) unsigned char lds[];
    LAS unsigned char* L = (LAS unsigned char*)lds;
    const int tid = threadIdx.x, lane = tid & 63, wave = __builtin_amdgcn_readfirstlane(tid >> 6);
    const int bid = blockIdx.x, G = gridDim.x;
    for (int u = tid; u < (LDS_BYTES - RING_BYTES) / 4; u += NTHR) ((LAS unsigned*)(L + RING_BYTES))[u] = 0u;
    __syncthreads();
    XcdBarrier bar = xcd_barrier_post((unsigned*)(a.ws + WS_CTL) + CW_BAR, (volatile LAS unsigned*)(L + MISC_OFF) + 8);
    bf16* XN = (bf16*)(a.ws + WS_XN); bf16* WI = (bf16*)(a.ws + WS_WI); bf16* WO = (bf16*)(a.ws + WS_WO); bf16* WPQ = (bf16*)(a.ws + WS_WPQ);

    {
        LAS float* scr = (LAS float*)(L + wave * 16384);
        const int gw = bid * NWAVES + wave, NGW = G * NWAVES;
        constexpr int I_IN = (D / 64) * (NPAD / 32), I_OUT = (D / 64) * (D / 32), I_PQ = (D / 64) * (2048 / 32);
        for (int it = gw; it < I_IN + I_OUT + I_PQ; it += NGW) {
            int r = it;
            if (r < I_IN) { transpose_item(a.in[IN_WIN], D, NPROJ, NPAD, WI, scr, r, lane); continue; } r -= I_IN;
            if (r < I_OUT) { transpose_item(a.in[IN_WOUT], D, D, D, WO, scr, r, lane); continue; } r -= I_OUT;
            transpose_item(a.in[IN_WPQ], D, 2048, 2048, WPQ, scr, r, lane);
        }
        for (int r = gw; r < 2 * 16384; r += NGW) {
            if (r < 16384) quant_row(a.in[IN_PU] + (size_t)r * D, a.ws + WS_UQ + (size_t)r * 1024, (float*)(a.ws + WS_USC) + r, 0, lane);
            else { const int rr = r - 16384; quant_row(a.in[IN_PV] + (size_t)rr * D, a.ws + WS_VQ + (size_t)rr * 1024, (float*)(a.ws + WS_VSC) + rr, 128, lane); }
        }
        for (int i = bid * NTHR + tid; i < 2 * 8 * 128 * 128; i += G * NTHR) {
            const int w = i >> 17, j = i & 131071;
            ((bf16*)(a.ws + WS_KEYS))[i] = (bf16)f2bf((w ? a.in[IN_KB] : a.in[IN_KA])[j]);
        }
        __syncthreads();
        phase_mod(a, bid, G, lds);
    }
    xcd_barrier(bar);
    phase_norm(a, a.in[IN_X], XN, 0, D, bid, G);
    xcd_barrier(bar);
    {
        pg8::Gemm g{XN, WI, T, NPAD, D}; pg8::StaticOrder S; S.init(T, NPAD, G, bid);
        pg8::EpiStoreBf16 E{(bf16*)(a.ws + WS_PROJ), NPAD};
        pg8::gemm_phase<pg8::EpiStoreBf16, pg8::StaticOrder, true, true>(L, g, S, E);
    }
    xcd_barrier(bar);
    phase_sb_simple(a, bid, G);
    phase_gla_local(a, bid, G, lds);
    xcd_barrier(bar);
    phase_gla_scan(a, bid, G);
    xcd_barrier(bar);
    phase_gla_out(a, bid, G, lds);
    xcd_barrier(bar);
    {
        pg8::Gemm g{(const bf16*)(a.ws + WS_MIXIN), WO, T, D, D}; pg8::StaticOrder S; S.init(T, D, G, bid);
        pg8::EpiResF32 E{a.in[IN_X], (const float*)(a.ws + WS_MOD), a.out, 2 * D};
        pg8::gemm_phase<pg8::EpiResF32, pg8::StaticOrder, true, true>(L, g, S, E);
    }
    xcd_barrier(bar);
    phase_norm(a, a.out, XN, 3 * D, 4 * D, bid, G);
    xcd_barrier(bar);
    {
        pg8::Gemm g{XN, WPQ, T, 2048, D}; pg8::StaticOrder S; S.init(T, 2048, G, bid);
        pg8::EpiStoreBf16 E{(bf16*)(a.ws + WS_QP), 2048};
        pg8::gemm_phase<pg8::EpiStoreBf16, pg8::StaticOrder, true, true>(L, g, S, E);
    }
    xcd_barrier(bar);
    phase_peer(a, bid, G, lds);
}

extern "C" void kernel_launch(void* const* d_in, const int* in_sizes, int n_in, void* d_out, int out_size, void* d_ws, size_t ws_size, hipStream_t stream) {
    static int grid = 0;
    if (grid == 0) {
        int dev = 0, cus = 0;
        if (hipGetDevice(&dev) != hipSuccess || hipDeviceGetAttribute(&cus, hipDeviceAttributeMultiprocessorCount, dev) != hipSuccess) { fprintf(stderr, "kernel_launch: device query failed\n"); grid = -1; return; }
        if (hipFuncSetAttribute((const void*)fwd_megakernel, hipFuncAttributeMaxDynamicSharedMemorySize, LDS_BYTES) != hipSuccess) { fprintf(stderr, "kernel_launch: hipFuncSetAttribute failed\n"); grid = -1; return; }
        int per_cu = 0;
        if (hipOccupancyMaxActiveBlocksPerMultiprocessor(&per_cu, (const void*)fwd_megakernel, NTHR, LDS_BYTES) != hipSuccess || per_cu < 1) fprintf(stderr, "kernel_launch: occupancy query reports %d\n", per_cu);
        (void)hipGetLastError();
        grid = cus;
    }
    if (grid < 0) return;
    (void)hipMemsetAsync((char*)d_ws + WS_CTL, 0, CTL_ZERO_BYTES, stream);
    Args a{};
    for (int i = 0; i < 16; ++i) a.in[i] = (const float*)d_in[i];
    a.out = (float*)d_out; a.ws = (unsigned char*)d_ws;
    hipLaunchKernelGGL(fwd_megakernel, dim3(grid), dim3(NTHR), LDS_BYTES, stream, a);
}
```

```cpp
#include <hip/hip_runtime.h>
#include <cstdio>
#include <cstdint>
namespace pg8 {
#define PG8_LAS __attribute__((address_space(3)))
typedef unsigned short bf16_t;
typedef short bf16x8 __attribute__((ext_vector_type(8)));
typedef float f32x4 __attribute__((ext_vector_type(4)));
typedef unsigned u32x4 __attribute__((ext_vector_type(4)));
constexpr int BM = 256, BK = 64, HALF = 128, HTB = HALF * BK * 2  , STAGE_BYTES = 8 * HTB, NXCD = 8, WGM = 8;

__host__ __device__ __forceinline__ int lds_byte(int r, int c) { const int st = (r >> 4) * 2 + (c >> 5), rr = r & 15, cc = c & 31, ob = rr * 64 + cc * 2; return st * 1024 + (ob ^ (((ob >> 9) & 1) << 5)); }
__host__ __device__ __forceinline__ void stage_rc(int b, int& R, int& C) { const int st = b / 1024, sb = b % 1024, swz = sb ^ (((sb >> 9) & 1) << 5); R = (st >> 1) * 16 + swz / 64; C = (st & 1) * 32 + (swz % 64) / 2; }
__host__ __device__ __forceinline__ int perm32(int rho) { const int n = rho >> 4, i = rho & 15; return 8 * (i >> 2) + 4 * n + (i & 3); }

struct Unit { int pm, pn; };
struct Gemm { const bf16_t* A; const bf16_t* Bt; int M, N, K; };

struct StaticOrder {
    int nM, nN, nwg, G, c;
    __host__ __device__ void init(int M, int N, int G_, int c_) { nM = M / BM; nN = N / BM; nwg = nM * nN; G = G_; c = c_; }
    __host__ __device__ bool next(int i, Unit& u) const {
        const long L = (long)i * G + c; if (L >= nwg) return false;
        int wgid = (int)L; { const int q = nwg / NXCD, r = nwg % NXCD, xcd = wgid % NXCD, off = wgid / NXCD; wgid = (xcd < r ? xcd * (q + 1) : r * (q + 1) + (xcd - r) * q) + off; }
        const int nig = WGM * nN, gid = wgid / nig, fm = gid * WGM, gsz = (nM - fm) < WGM ? (nM - fm) : WGM;
        u.pm = fm + ((wgid % nig) % gsz); u.pn = (wgid % nig) / gsz; return true;
    }
    __device__ __forceinline__ void a_ready(const Unit&) const {}
    __device__ __forceinline__ void done(const Unit&) const {}
};

__device__ __forceinline__ unsigned cvt_pk_bf16(float lo, float hi) { unsigned r; asm volatile("v_cvt_pk_bf16_f32 %0, %1, %2" : "=v"(r) : "v"(lo), "v"(hi)); return r; }
struct EpiStoreBf16 {
    static constexpr bool PERM = true, AFTER_DRAIN = false;
    bf16_t* O; int ldc;
    __device__ __forceinline__ void operator()(const f32x4 (&acc)[2][2][4][2], const Unit& u, int wr, int wc, int fr, int fq) const {
        const int row0 = u.pm * BM + wr * 64 + fr, col0 = u.pn * BM + wc * 32 + 8 * fq;
#pragma unroll
        for (int ai = 0; ai < 2; ++ai)
#pragma unroll
            for (int m = 0; m < 4; ++m) { bf16_t* rowp = O + (size_t)(row0 + ai * HALF + m * 16) * ldc + col0;
#pragma unroll
                for (int bj = 0; bj < 2; ++bj) { const f32x4 v0 = acc[ai][bj][m][0], v1 = acc[ai][bj][m][1];
                    u32x4 w; w.x = cvt_pk_bf16(v0[0], v0[1]); w.y = cvt_pk_bf16(v0[2], v0[3]); w.z = cvt_pk_bf16(v1[0], v1[1]); w.w = cvt_pk_bf16(v1[2], v1[3]);
                    *(u32x4*)(rowp + bj * HALF) = w; } }
    }
};
struct EpiResF32 {
    static constexpr bool PERM = true, AFTER_DRAIN = false;
    const float* x; const float* mod; float* out; int goff;
    __device__ __forceinline__ void operator()(const f32x4 (&acc)[2][2][4][2], const Unit& u, int wr, int wc, int fr, int fq) const {
        const int row0 = u.pm * BM + wr * 64 + fr, col0 = u.pn * BM + wc * 32 + 8 * fq;
        const float* g = mod + (u.pm >> 5) * 6144 + goff + col0;
        f32x4 gv[2][2];
#pragma unroll
        for (int bj = 0; bj < 2; ++bj)
#pragma unroll
            for (int n = 0; n < 2; ++n) gv[bj][n] = *(const f32x4*)(g + bj * HALF + 4 * n);
#pragma unroll
        for (int ai = 0; ai < 2; ++ai)
#pragma unroll
            for (int m = 0; m < 4; ++m) { const size_t ro = (size_t)(row0 + ai * HALF + m * 16) * 1024 + col0;
#pragma unroll
                for (int bj = 0; bj < 2; ++bj)
#pragma unroll
                    for (int n = 0; n < 2; ++n) { const f32x4 xv = *(const f32x4*)(x + ro + bj * HALF + 4 * n);
                        *(f32x4*)(out + ro + bj * HALF + 4 * n) = xv + gv[bj][n] * acc[ai][bj][m][n]; } }
    }
};

struct ProjOrder {
    StaticOrder so;
    __host__ __device__ void init(int G_, int c_) { so.init(64 * BM, 13 * BM, G_, c_); }
    __host__ __device__ bool next(int i, Unit& u) const { Unit v; if (!so.next(i, v)) return false; if (v.pn < 11) { u.pm = v.pm; u.pn = 64 + v.pn; } else { u.pm = 64 + v.pn; u.pn = v.pm; } return true; }
    __device__ __forceinline__ void a_ready(const Unit&) const {}
    __device__ __forceinline__ void done(const Unit&) const {}
};
struct EpiProj {
    static constexpr bool PERM = true, AFTER_DRAIN = false;
    bf16_t* P; bf16_t* VT;
    __device__ __forceinline__ void operator()(const f32x4 (&acc)[2][2][4][2], const Unit& u, int wr, int wc, int fr, int fq) const {
        const bool tr = u.pm >= 64;
        bf16_t* O = tr ? VT : P; const int ldc = tr ? 16384 : 2816;
        const int row0 = (tr ? (u.pm - 75) : u.pm) * BM + wr * 64 + fr, col0 = (tr ? u.pn : (u.pn - 64)) * BM + wc * 32 + 8 * fq;
#pragma unroll
        for (int ai = 0; ai < 2; ++ai)
#pragma unroll
            for (int m = 0; m < 4; ++m) { bf16_t* rowp = O + (size_t)(row0 + ai * HALF + m * 16) * ldc + col0;
#pragma unroll
                for (int bj = 0; bj < 2; ++bj) { const f32x4 v0 = acc[ai][bj][m][0], v1 = acc[ai][bj][m][1];
                    u32x4 w; w.x = cvt_pk_bf16(v0[0], v0[1]); w.y = cvt_pk_bf16(v0[2], v0[3]); w.z = cvt_pk_bf16(v1[0], v1[1]); w.w = cvt_pk_bf16(v1[2], v1[3]);
                    *(u32x4*)(rowp + bj * HALF) = w; } }
    }
};
template <class Epi, class Sched, bool ALIGN_EPI = false, bool SP2 = false>
__device__ __forceinline__ void gemm_phase(PG8_LAS unsigned char* lds, const Gemm g, const Sched& S, const Epi& E) {
    const int tid = threadIdx.x, wid = __builtin_amdgcn_readfirstlane(tid >> 6), lane = tid & 63, wr = wid >> 2, wc = wid & 3, fr = lane & 15, fq = lane >> 4;
    const int K = g.K, nt = K / BK;
    unsigned voffA[2], voffB[2];
#pragma unroll
    for (int i = 0; i < 2; ++i) { int R, C; stage_rc(tid * 16 + i * 8192, R, C); const int Rb = Epi::PERM ? ((R & ~31) + perm32(R & 31)) : R;
        voffA[i] = (unsigned)(R * K + C) * 2u; voffB[i] = (unsigned)(Rb * K + C) * 2u; }
    const size_t kstep = (size_t)(BK * 2);
    const size_t hstep = (size_t)HALF * K * 2;
    const size_t tstep = 2 * hstep;
    const unsigned ldsw = (unsigned)wid * 1024u;
    const int aoff = lds_byte(wr * 64 + fr, fq * 8), boff = lds_byte(wc * 32 + fr, fq * 8);
#define PG8_SA(b, h) (((b) * 2 + (h)) * HTB)
#define PG8_SB(b, h) ((4 + (b) * 2 + (h)) * HTB)
#define PG8_STAGE(bufoff, gbase, voff) do { _Pragma("unroll") for (int _i = 0; _i < 2; ++_i) \
        __builtin_amdgcn_global_load_lds((const unsigned*)((const char*)(gbase) + (voff)[_i]), (PG8_LAS unsigned*)(lds + (bufoff) + ldsw + _i * 8192), 16, 0, 0); } while (0)
#define PG8_LDA(dst, b, h) do { _Pragma("unroll") for (int m = 0; m < 4; ++m) _Pragma("unroll") for (int k = 0; k < 2; ++k) dst[m][k] = *(const PG8_LAS bf16x8*)(lds + PG8_SA(b, h) + aoff + m * 2048 + k * 1024); } while (0)
#define PG8_LDB(dst, b, h) do { _Pragma("unroll") for (int n = 0; n < 2; ++n) _Pragma("unroll") for (int k = 0; k < 2; ++k) dst[n][k] = *(const PG8_LAS bf16x8*)(lds + PG8_SB(b, h) + boff + n * 2048 + k * 1024); } while (0)
#define PG8_MMA(ai, bj, At, Bt) do { __builtin_amdgcn_s_setprio(1); _Pragma("unroll") for (int m = 0; m < 4; ++m) _Pragma("unroll") for (int n = 0; n < 2; ++n) _Pragma("unroll") for (int k = 0; k < 2; ++k) \
        acc[ai][bj][m][n] = __builtin_amdgcn_mfma_f32_16x16x32_bf16(Bt[n][k], At[m][k], acc[ai][bj][m][n], 0, 0, 0); __builtin_amdgcn_s_setprio(0); } while (0)
#define PG8_WAIT_V(n) asm volatile("s_waitcnt vmcnt(" #n ")" ::: "memory")
#define PG8_WAIT_L(n) asm volatile("s_waitcnt lgkmcnt(" #n ")" ::: "memory")
#define PG8_BAR __builtin_amdgcn_s_barrier()
#define PG8_SCHED __builtin_amdgcn_sched_barrier(0)
    Unit cur, nxt; int ui = 0;
    if (!S.next(0, cur)) return;
    f32x4 acc[2][2][4][2];
#pragma unroll
    for (int a = 0; a < 2; ++a)
#pragma unroll
        for (int b = 0; b < 2; ++b)
#pragma unroll
            for (int m = 0; m < 4; ++m)
#pragma unroll
                for (int n = 0; n < 2; ++n) acc[a][b][m][n] = (f32x4){0.f, 0.f, 0.f, 0.f};
    bf16x8 At[4][2], B0[2][2], B1[2][2];
    const char* cA = (const char*)g.A + (size_t)cur.pm * tstep; const char* cB = (const char*)g.Bt + (size_t)cur.pn * tstep;
    S.a_ready(cur);
    if constexpr (SP2) {
        PG8_STAGE(PG8_SB(0, 0), cB, voffB); PG8_STAGE(PG8_SB(0, 1), cB + hstep, voffB); PG8_STAGE(PG8_SA(0, 0), cA, voffA); PG8_STAGE(PG8_SA(0, 1), cA + hstep, voffA);
        if (wr == 1) PG8_BAR;
        PG8_WAIT_V(2); PG8_BAR;
        PG8_STAGE(PG8_SB(1, 0), cB + kstep, voffB); PG8_STAGE(PG8_SA(1, 0), cA + kstep, voffA); PG8_STAGE(PG8_SB(1, 1), cB + hstep + kstep, voffB);
        PG8_WAIT_V(6); PG8_BAR;
    } else {
        PG8_STAGE(PG8_SB(0, 0), cB, voffB); PG8_STAGE(PG8_SA(0, 0), cA, voffA); PG8_STAGE(PG8_SB(0, 1), cB + hstep, voffB); PG8_STAGE(PG8_SA(0, 1), cA + hstep, voffA);
        if (wr == 1) PG8_BAR;
        PG8_WAIT_V(4); PG8_BAR;
        PG8_STAGE(PG8_SB(1, 0), cB + kstep, voffB); PG8_STAGE(PG8_SA(1, 0), cA + kstep, voffA); PG8_STAGE(PG8_SB(1, 1), cB + hstep + kstep, voffB);
        PG8_WAIT_V(6); PG8_BAR;
    }
    for (;;) {
        const bool has_next = S.next(ui + 1, nxt);
        const char* nA = has_next ? (const char*)g.A + (size_t)nxt.pm * tstep : cA; const char* nB = has_next ? (const char*)g.Bt + (size_t)nxt.pn * tstep : cB;
        for (int t = 0; t < nt; t += 2) {
            const bool last = (t == nt - 2);
            const char* a1 = cA + (size_t)(t + 1) * kstep;
            const char* a2 = last ? nA : cA + (size_t)(t + 2) * kstep; const char* b2 = last ? nB : cB + (size_t)(t + 2) * kstep;
            const char* a3 = a2 + kstep; const char* b3 = b2 + kstep;
            if (last && has_next) S.a_ready(nxt);
            if constexpr (SP2) {
            PG8_LDB(B0, 0, 0); PG8_LDB(B1, 0, 1); PG8_SCHED; PG8_LDA(At, 0, 0); PG8_STAGE(PG8_SA(1, 1), a1 + hstep, voffA);
            PG8_WAIT_V(8); PG8_WAIT_L(0); PG8_BAR; PG8_MMA(0, 0, At, B0); PG8_MMA(0, 1, At, B1); PG8_BAR; PG8_SCHED;
            PG8_LDA(At, 0, 1); PG8_STAGE(PG8_SB(0, 0), b2, voffB); PG8_STAGE(PG8_SB(0, 1), b2 + hstep, voffB); PG8_STAGE(PG8_SA(0, 0), a2, voffA);
            PG8_WAIT_V(8); PG8_WAIT_L(0); PG8_BAR; PG8_MMA(1, 0, At, B0); PG8_MMA(1, 1, At, B1); PG8_BAR; PG8_SCHED;
            PG8_LDB(B0, 1, 0); PG8_LDB(B1, 1, 1); PG8_SCHED; PG8_LDA(At, 1, 0); PG8_STAGE(PG8_SA(0, 1), a2 + hstep, voffA);
            PG8_WAIT_V(8); PG8_WAIT_L(0); PG8_BAR; PG8_MMA(0, 0, At, B0); PG8_MMA(0, 1, At, B1); PG8_BAR; PG8_SCHED;
            PG8_LDA(At, 1, 1); PG8_STAGE(PG8_SB(1, 0), b3, voffB); PG8_STAGE(PG8_SB(1, 1), b3 + hstep, voffB); PG8_STAGE(PG8_SA(1, 0), a3, voffA);
            PG8_WAIT_V(8); PG8_WAIT_L(0); PG8_BAR; PG8_MMA(1, 0, At, B0); PG8_MMA(1, 1, At, B1); PG8_BAR; PG8_SCHED;
            } else {
            PG8_LDB(B0, 0, 0); PG8_SCHED; PG8_LDA(At, 0, 0); PG8_STAGE(PG8_SA(1, 1), a1 + hstep, voffA);
            PG8_WAIT_L(8); PG8_BAR; PG8_WAIT_L(0); PG8_MMA(0, 0, At, B0); PG8_BAR; PG8_SCHED;
            PG8_LDB(B1, 0, 1); PG8_STAGE(PG8_SB(0, 0), b2, voffB);
            PG8_BAR; PG8_WAIT_L(0); PG8_MMA(0, 1, At, B1); PG8_BAR;
            PG8_LDA(At, 0, 1); PG8_STAGE(PG8_SA(0, 0), a2, voffA);
            PG8_BAR; PG8_WAIT_L(0); PG8_MMA(1, 0, At, B0); PG8_BAR; PG8_SCHED;
            PG8_STAGE(PG8_SB(0, 1), b2 + hstep, voffB);
            PG8_WAIT_V(6); PG8_BAR; PG8_MMA(1, 1, At, B1); PG8_BAR;
            PG8_LDB(B0, 1, 0); PG8_SCHED; PG8_LDA(At, 1, 0); PG8_STAGE(PG8_SA(0, 1), a2 + hstep, voffA);
            PG8_WAIT_L(8); PG8_BAR; PG8_WAIT_L(0); PG8_MMA(0, 0, At, B0); PG8_BAR; PG8_SCHED;
            PG8_LDB(B1, 1, 1); PG8_STAGE(PG8_SB(1, 0), b3, voffB);
            PG8_BAR; PG8_WAIT_L(0); PG8_MMA(0, 1, At, B1); PG8_BAR;
            PG8_LDA(At, 1, 1); PG8_STAGE(PG8_SA(1, 0), a3, voffA);
            PG8_BAR; PG8_WAIT_L(0); PG8_MMA(1, 0, At, B0); PG8_BAR; PG8_SCHED;
            PG8_STAGE(PG8_SB(1, 1), b3 + hstep, voffB);
            PG8_WAIT_V(6); PG8_BAR; PG8_MMA(1, 1, At, B1); PG8_BAR;
            }
        }
        if constexpr (ALIGN_EPI) { if (wr == 0) PG8_BAR; }
        if constexpr (!Epi::AFTER_DRAIN) { E(acc, cur, wr, wc, fr, fq); S.done(cur); }
        if (!has_next) break;
#pragma unroll
        for (int a = 0; a < 2; ++a)
#pragma unroll
            for (int b = 0; b < 2; ++b)
#pragma unroll
                for (int m = 0; m < 4; ++m)
#pragma unroll
                    for (int n = 0; n < 2; ++n) acc[a][b][m][n] = (f32x4){0.f, 0.f, 0.f, 0.f};
        cur = nxt; cA = nA; cB = nB; ++ui;
        if constexpr (ALIGN_EPI) { if (wr == 1) PG8_BAR; }
    }
    PG8_WAIT_V(0);
    if constexpr (!ALIGN_EPI) { if (wr == 0) PG8_BAR; }
    PG8_BAR;
    if constexpr (Epi::AFTER_DRAIN) { E.fused(acc, cur, wr, wc, fr, fq, lds, wid, lane); S.done(cur); }
#undef PG8_SA
#undef PG8_SB
#undef PG8_STAGE
#undef PG8_LDA
#undef PG8_LDB
#undef PG8_MMA
#undef PG8_WAIT_V
#undef PG8_WAIT_L
#undef PG8_BAR
#undef PG8_SCHED
}
}
#define GAS __attribute__((address_space(1)))
#define LAS __attribute__((address_space(3)))
typedef unsigned short bf16;
typedef unsigned v4u __attribute__((ext_vector_type(4)));
typedef float f32x4 __attribute__((ext_vector_type(4)));
typedef short bf16x8 __attribute__((ext_vector_type(8)));
typedef GAS unsigned gu32;
typedef GAS unsigned long long gu64;
#define RLX_AGENT __ATOMIC_RELAXED, __HIP_MEMORY_SCOPE_AGENT
#define LDS_WAIT() asm volatile("s_waitcnt lgkmcnt(0)" ::: "memory")
#define VM_WAIT() asm volatile("s_waitcnt vmcnt(0)" ::: "memory")
__device__ __forceinline__ unsigned long long rt() { return __builtin_amdgcn_s_memrealtime(); }
__device__ __forceinline__ unsigned f2bf(float f) { unsigned u = __builtin_bit_cast(unsigned, f); return (u + 0x7fffu + ((u >> 16) & 1u)) >> 16; }
__device__ __forceinline__ unsigned pk2(float lo, float hi) { return f2bf(lo) | (f2bf(hi) << 16); }

#define XB_TMO      128
#define XB_XCNT(j)  (256  + 64 * (j))
#define XB_XSUB(j)  (1280 + 64 * (j))
#define XB_XGEN(j)  (2304 + 64 * (j))
#define XB_TOP      3328
#define XB_TOPGEN   3392
#define XCD_BAR_WORDS 3456
#define XB_SPIN_CAP (1u << 18)

__device__ __forceinline__ unsigned xb_ld(unsigned* p)              { return __hip_atomic_load(p, __ATOMIC_RELAXED, __HIP_MEMORY_SCOPE_AGENT); }
__device__ __forceinline__ unsigned xb_add(unsigned* p, unsigned v) { return __hip_atomic_fetch_add(p, v, __ATOMIC_RELAXED, __HIP_MEMORY_SCOPE_AGENT); }
__device__ __forceinline__ unsigned xb_xcc_id() { return (unsigned)__builtin_amdgcn_s_getreg((3 << 11) | 20) & 0xFu; }
#define XB_SPIN(cond, bar) do { unsigned _sp = 0; while (cond) { __builtin_amdgcn_s_sleep(1); \
    if ((++_sp & 255u) == 0u) { if (xb_ld(&(bar)[XB_TMO])) break; if (_sp > XB_SPIN_CAP) { atomicAdd(&(bar)[XB_TMO], 1u); break; } } } } while (0)

struct XcdBarrier {
    unsigned* bar; unsigned x;
    volatile LAS unsigned* st;
};

__device__ __forceinline__ XcdBarrier xcd_barrier_post(unsigned* bar, volatile LAS unsigned* st) {
    XcdBarrier b; b.bar = bar; b.x = xb_xcc_id(); b.st = st;
    if (threadIdx.x == 0) (void)xb_add(&bar[XB_XCNT(b.x)], 1u);
    return b;
}
__device__ __forceinline__ void xcd_barrier_complete(unsigned* bar, unsigned x, unsigned& nloc, unsigned& nx) {
    const unsigned G = gridDim.x * gridDim.y * gridDim.z;
    unsigned sum, cnt, mine, sp = 0u;
    for (;;) {
        sum = 0u; cnt = 0u; mine = 0u;
#pragma unroll
        for (unsigned j = 0; j < 16; ++j) { const unsigned c = xb_ld(&bar[XB_XCNT(j)]); sum += c; cnt += (c > 0u) ? 1u : 0u; mine = (j == x) ? c : mine; }
        if (sum == G) break;
        __builtin_amdgcn_s_sleep(1);
        if ((++sp & 255u) == 0u) { if (xb_ld(&bar[XB_TMO])) break; if (sp > XB_SPIN_CAP) { atomicAdd(&bar[XB_TMO], 1u); break; } }
    }
    nloc = mine > 0u ? mine : 1u; nx = cnt > 0u ? cnt : 1u;
}

__device__ __forceinline__ void xcd_barrier(const XcdBarrier& b) {
    asm volatile("s_waitcnt vmcnt(0)" ::: "memory");
    __syncthreads();
    if (threadIdx.x == 0) {
        unsigned* bar = b.bar;
        __builtin_amdgcn_s_waitcnt(0);
        unsigned nloc = b.st[0], nx = b.st[1];
        if (nloc == 0u) { xcd_barrier_complete(bar, b.x, nloc, nx); b.st[0] = nloc; b.st[1] = nx; }
        const unsigned old = xb_add(&bar[XB_XSUB(b.x)], 1u);
        const unsigned gen = old / nloc;
        if (old + 1u == (gen + 1u) * nloc) {
            __builtin_amdgcn_fence(__ATOMIC_RELEASE, "agent");
            asm volatile("s_waitcnt vmcnt(0)" ::: "memory");
            const unsigned og = xb_add(&bar[XB_TOP], 1u);
            const unsigned tg = og / nx;
            if (og + 1u == (tg + 1u) * nx) xb_add(&bar[XB_TOPGEN], 1u);
            else XB_SPIN(xb_ld(&bar[XB_TOPGEN]) == tg, bar);
            __builtin_amdgcn_fence(__ATOMIC_ACQUIRE, "agent");
            xb_add(&bar[XB_XGEN(b.x)], 1u);
            asm volatile("s_waitcnt vmcnt(0)" ::: "memory");
        } else {
            XB_SPIN(xb_ld(&bar[XB_XGEN(b.x)]) == gen, bar);
            __builtin_amdgcn_fence(__ATOMIC_ACQUIRE, "agent");
            asm volatile("s_waitcnt vmcnt(0)" ::: "memory");
        }
    }
    __syncthreads();
}
#ifndef PROBE_REP
#define PROBE_REP -1
#endif
#define NREP(k) ((PROBE_REP) == (k) ? 2 : 1)
constexpr int T = 16384, D = 1024, SEQ = 8192, NPROJ = 3088, NPAD = 3328, LDP = 2816, NWAVES = 8, NTHR = 512;
constexpr int OFF_SBQ = 0, OFF_SBK = 512, OFF_GQ = 1024, OFF_GK = 1280, OFF_GV = 1536, OFF_GR = 2048, OFF_GLR = 2560;
constexpr float EPS = 1e-6f;
constexpr size_t MiB = 1u << 20;
constexpr size_t WS_CTL = 0, CTL_ZERO_BYTES = 64 * 1024, WS_MOD = 256 * 1024;
constexpr size_t WS_XN = 1 * MiB, WS_WI = 33 * MiB  , WS_WO = 40 * MiB, WS_WPQ = 42 * MiB, WS_KEYS = 46 * MiB;
constexpr size_t WS_PROJ = 48 * MiB, WS_VT = 136 * MiB  , WS_MIXIN = 152 * MiB, WS_QP = 48 * MiB, WS_IDX = 112 * MiB, WS_GATE = 120 * MiB;
constexpr size_t WS_UQ = 184 * MiB, WS_VQ = 200 * MiB, WS_USC = 216 * MiB, WS_VSC = 216 * MiB + 65536;
constexpr size_t DO_DS = 0, DO_GS = 32 * MiB, DO_SST = 33 * MiB;
constexpr int CW_BAR = 4096;
constexpr int RING_BYTES = 131072, MISC_OFF = RING_BYTES + 320, LDS_BYTES = 147456;

__device__ __forceinline__ float bflo(unsigned w) { return __uint_as_float(w << 16); }
__device__ __forceinline__ float bfhi(unsigned w) { return __uint_as_float(w & 0xffff0000u); }
__device__ __forceinline__ float bf2f(bf16 v) { return __uint_as_float((unsigned)v << 16); }
__device__ __forceinline__ float wave_sum(float v) {
#pragma unroll
    for (int o = 1; o < 64; o <<= 1) v += __shfl_xor(v, o);
    return v;
}
__device__ __forceinline__ float softplusf(float z) { return fmaxf(z, 0.f) + log1pf(expf(-fabsf(z))); }
__device__ __forceinline__ float siluf(float v) { return v / (1.f + expf(-v)); }

struct Args { const float* in[16]; float* out; unsigned char* ws; };
#define IN_X 0
#define IN_C 1
#define IN_WADA 2
#define IN_BADA 3
#define IN_WIN 4
#define IN_WUP 5
#define IN_BGATE 6
#define IN_GSB 7
#define IN_GGLA 8
#define IN_WOUT 9
#define IN_WPQ 10
#define IN_KA 11
#define IN_KB 12
#define IN_PU 13
#define IN_PV 14
#define IN_GF 15

__device__ __forceinline__ int win_src(int r) {
    if (r < 1024) return r;
    if (r < 1536) return r + 512;
    if (r < 2048) return r + 512;
    if (r < 2560) return r - 2048 + 2576;
    if (r < 2576) return r;
    if (r < 2816) return -1;
    return r - 2816 + 1024;
}
template <bool MAP>
__device__ __forceinline__ void transpose_item(const float* W, int K, int N, int Npad, bf16* WT, LAS float* scr, int item, int lane) {
    const int nblk = Npad / 32, kb = item / nblk, nb = item % nblk, k0 = 64 * kb, n0 = 32 * nb;
    const int n_in = MAP ? win_src(n0 + (lane & 31)) : n0 + (lane & 31); const bool ok = n_in >= 0 && n_in < N;
#pragma unroll 8
    for (int i = 0; i < 32; ++i) { const int kk = 2 * i + (lane >> 5); scr[kk * 33 + (lane & 31)] = ok ? W[(size_t)(k0 + kk) * N + n_in] : 0.f; }
    LDS_WAIT(); asm volatile("" ::: "memory");
    const int c = lane & 7;
#pragma unroll
    for (int j = 0; j < 4; ++j) { const int n = (lane >> 3) + 8 * j; const LAS float* s = scr + (8 * c) * 33 + n;
        v4u o; o.x = pk2(s[0 * 33], s[1 * 33]); o.y = pk2(s[2 * 33], s[3 * 33]); o.z = pk2(s[4 * 33], s[5 * 33]); o.w = pk2(s[6 * 33], s[7 * 33]);
        *(GAS v4u*)(WT + (size_t)(n0 + n) * K + k0 + 8 * c) = o; }
    LDS_WAIT(); asm volatile("" ::: "memory");
}
__device__ __forceinline__ void phase_mod(const Args& a, int bid, int nb, unsigned char* lds) {
    float* scr = (float*)lds;
    float* mod = (float*)(a.ws + WS_MOD);
    const float* c = a.in[IN_C]; const float* w_ada = a.in[IN_WADA]; const float* b_ada = a.in[IN_BADA];
    const int tid = threadIdx.x;
    for (int chunk = bid; chunk < 256; chunk += nb) {
        if (tid < 504) {
            const int col = tid % 24, kg = tid / 24, n = chunk * 24 + col; float a0 = 0.f, a1 = 0.f;
            for (int k = kg; k < D; k += 21) { const float w = w_ada[(size_t)k * 6144 + n]; a0 += siluf(c[k]) * w; a1 += siluf(c[D + k]) * w; }
            scr[kg * 48 + col] = a0; scr[kg * 48 + 24 + col] = a1;
        }
        __syncthreads();
        if (tid < 48) { float s = 0.f; for (int kg = 0; kg < 21; ++kg) s += scr[kg * 48 + tid];
            const int b = tid / 24, n = chunk * 24 + tid % 24; mod[b * 6144 + n] = s + b_ada[n]; }
        __syncthreads();
    }
}
__device__ __forceinline__ void norm_row_to_bf16(const float* xrow, bf16* orow, const float* modb, int shift_off, int scale_off, int lane) {
    const f32x4* xr = (const f32x4*)xrow + lane;
    f32x4 v[4]; float ss = 0.f;
#pragma unroll
    for (int j = 0; j < 4; ++j) { v[j] = xr[64 * j]; ss += (v[j].x * v[j].x + v[j].y * v[j].y) + (v[j].z * v[j].z + v[j].w * v[j].w); }
    const float r = rsqrtf(wave_sum(ss) * (1.f / D) + EPS);
    unsigned long long* o8 = (unsigned long long*)orow + lane;
#pragma unroll
    for (int j = 0; j < 4; ++j) {
        const int col = 4 * lane + 256 * j;
        const f32x4 sc = *(const f32x4*)(modb + scale_off + col), sh = *(const f32x4*)(modb + shift_off + col);
        const f32x4 o = v[j] * r * (sc + 1.f) + sh;
        o8[64 * j] = (unsigned long long)pk2(o.x, o.y) | ((unsigned long long)pk2(o.z, o.w) << 32);
    }
}
__device__ __forceinline__ void phase_norm(const Args& a, const float* src, bf16* dst, int shift_off, int scale_off, int bid, int nb) {
    const float* mod = (const float*)(a.ws + WS_MOD);
    const int lane = threadIdx.x & 63, wave = threadIdx.x >> 6;
    for (int row = bid * NWAVES + wave; row < T; row += nb * NWAVES)
        norm_row_to_bf16(src + (size_t)row * D, dst + (size_t)row * D, mod + (row / SEQ) * 6144, shift_off, scale_off, lane);
}

typedef float f32x16s __attribute__((ext_vector_type(16)));
typedef short bf8s __attribute__((ext_vector_type(8)));
__device__ __forceinline__ bf8s bl16(__amdgpu_buffer_rsrc_t r, unsigned voff, unsigned soff) { return __builtin_bit_cast(bf8s, __builtin_amdgcn_raw_buffer_load_b128(r, voff, soff, 0)); }
__device__ __forceinline__ unsigned pk2bf(float lo, float hi) { typedef float f2 __attribute__((ext_vector_type(2))); typedef __bf16 b2 __attribute__((ext_vector_type(2))); f2 v = {lo, hi}; b2 b = __builtin_convertvector(v, b2); return __builtin_bit_cast(unsigned, b); }
__device__ void phase_sb(const Args& a, int bid, int nb) {
    const bf16* proj = (const bf16*)(a.ws + WS_PROJ); const bf16* vt = (const bf16*)(a.ws + WS_VT); bf16* mixin = (bf16*)(a.ws + WS_MIXIN); const float* g_sb = a.in[IN_GSB];
    const int lane = threadIdx.x & 63, wave = threadIdx.x >> 6, c31 = lane & 31, hp = lane >> 5;
    const __amdgpu_buffer_rsrc_t prs = __builtin_amdgcn_make_buffer_rsrc((void*)proj, (short)0, T * LDP * 2, 0x00020000);
    const __amdgpu_buffer_rsrc_t vrs = __builtin_amdgcn_make_buffer_rsrc((void*)vt, (short)0, 512 * 16384 * 2, 0x00020000);
    const int pi = (c31 & 19) | ((c31 & 4) << 1) | ((c31 & 8) >> 1);
    constexpr float SC = 0.125f * 1.4426950408889634f;
    for (int unit = bid; unit < 512; unit += nb) {
        const int bh = unit & 15, qb = 31 - (unit >> 4), b = bh >> 3, h = bh & 7;
        const int q0 = qb * 256 + wave * 32;
        bf8s bq[4];
        { const unsigned qoff = ((unsigned)(b * SEQ + q0 + c31) * LDP + OFF_SBQ + h * 64 + 8 * hp) * 2u;
#pragma unroll
          for (int s = 0; s < 4; ++s) bq[s] = bl16(prs, qoff + 32 * s, 0); }
        f32x16s o0, o1;
#pragma unroll
        for (int r = 0; r < 16; ++r) { o0[r] = 0.f; o1[r] = 0.f; }
        float C = 0.f;
        unsigned koff = ((unsigned)(b * SEQ + q0 + pi) * LDP + OFF_SBK + h * 64 + 8 * hp) * 2u;
        unsigned voff = ((unsigned)(h * 64 + c31) * 16384u + (unsigned)(b * SEQ + q0) + 8 * hp) * 2u;
        for (int kt = q0 >> 5; kt >= 0; --kt) {
            const bool diag = (kt == (q0 >> 5));
            bf8s ak[4], av[4];
#pragma unroll
            for (int s = 0; s < 4; ++s) ak[s] = bl16(prs, koff + 32 * s, 0);
#pragma unroll
            for (int i = 0; i < 4; ++i) av[i] = bl16(vrs, voff + 32 * (i & 1), (i >> 1) * (32 * 16384 * 2));
            f32x16s z;
#pragma unroll
            for (int r = 0; r < 16; ++r) z[r] = 0.f;
#pragma unroll
            for (int s = 0; s < 4; ++s) z = __builtin_amdgcn_mfma_f32_32x32x16_bf16(ak[s], bq[s], z, 0, 0, 0);
            float sp[16], lo = 0.f, hi = 0.f;
#pragma unroll
            for (int r = 0; r < 16; ++r) {
                const float z2 = z[r] * SC;
                const float e = __builtin_amdgcn_exp2f(-fabsf(z2));
                float v = fmaxf(z2, 0.f) + __builtin_amdgcn_logf(1.f + e);
                if (diag && ((r & 7) + 8 * hp + 16 * (r >> 3) >= c31)) v = 0.f;
                sp[r] = v; z[r] = z2;
                if (r < 8) lo += v; else hi += v;
            }
            const float plo = __shfl_xor(lo, 32), phi = __shfl_xor(hi, 32);
            const float Chi = hp ? C : C + phi;
            const float Clo = hp ? C + hi + phi : C + phi + hi + plo;
            C = C + lo + hi + plo + phi;
            float w[16];
            {
                float run = Chi;
#pragma unroll
                for (int r = 15; r >= 8; --r) { w[r] = __builtin_amdgcn_exp2f(z[r] - sp[r] - run); run += sp[r]; }
                run = Clo;
#pragma unroll
                for (int r = 7; r >= 0; --r) { w[r] = __builtin_amdgcn_exp2f(z[r] - sp[r] - run); run += sp[r]; }
            }
            if (diag) {
#pragma unroll
                for (int r = 0; r < 16; ++r) if ((r & 7) + 8 * hp + 16 * (r >> 3) >= c31) w[r] = 0.f;
            }
            v4u p0, p1;
#pragma unroll
            for (int j = 0; j < 4; ++j) { p0[j] = pk2bf(w[2 * j], w[2 * j + 1]); p1[j] = pk2bf(w[8 + 2 * j], w[8 + 2 * j + 1]); }
            const bf8s pb0 = __builtin_bit_cast(bf8s, p0), pb1 = __builtin_bit_cast(bf8s, p1);
            o0 = __builtin_amdgcn_mfma_f32_32x32x16_bf16(av[0], pb0, o0, 0, 0, 0);
            o0 = __builtin_amdgcn_mfma_f32_32x32x16_bf16(av[1], pb1, o0, 0, 0, 0);
            o1 = __builtin_amdgcn_mfma_f32_32x32x16_bf16(av[2], pb0, o1, 0, 0, 0);
            o1 = __builtin_amdgcn_mfma_f32_32x32x16_bf16(av[3], pb1, o1, 0, 0, 0);
            if (__builtin_amdgcn_ballot_w64(C < 150.f) == 0ull) break;
            koff -= 32u * LDP * 2u; voff -= 64u;
        }
        float ss = 0.f;
#pragma unroll
        for (int r = 0; r < 16; ++r) ss += o0[r] * o0[r] + o1[r] * o1[r];
        ss += __shfl_xor(ss, 32);
        const float rn = rsqrtf(ss * (1.f / 64.f) + EPS);
        bf16* orow = mixin + (size_t)(b * SEQ + q0 + c31) * D + h * 64;
#pragma unroll
        for (int g = 0; g < 4; ++g) {
            const int d = 8 * g + 4 * hp;
            const f32x4 g0 = *(const f32x4*)(g_sb + h * 64 + d), g1 = *(const f32x4*)(g_sb + h * 64 + 32 + d);
            *(uint2*)(orow + d) = make_uint2(pk2bf(o0[4 * g] * rn * g0.x, o0[4 * g + 1] * rn * g0.y), pk2bf(o0[4 * g + 2] * rn * g0.z, o0[4 * g + 3] * rn * g0.w));
            *(uint2*)(orow + 32 + d) = make_uint2(pk2bf(o1[4 * g] * rn * g1.x, o1[4 * g + 1] * rn * g1.y), pk2bf(o1[4 * g + 2] * rn * g1.z, o1[4 * g + 3] * rn * g1.w));
        }
    }
}
__device__ __forceinline__ void quant_row(const float* row, unsigned char* q, float* scale_out, int bias, int lane) {
    const f32x4* r4 = (const f32x4*)row + lane * 4;
    f32x4 v[4]; float am = 0.f;
#pragma unroll
    for (int j = 0; j < 4; ++j) { v[j] = r4[j]; am = fmaxf(fmaxf(am, fmaxf(fabsf(v[j].x), fabsf(v[j].y))), fmaxf(fabsf(v[j].z), fabsf(v[j].w))); }
#pragma unroll
    for (int o = 1; o < 64; o <<= 1) am = fmaxf(am, __shfl_xor(am, o));
    const float inv = am > 0.f ? 127.f / am : 0.f;
    v4u w;
#pragma unroll
    for (int j = 0; j < 4; ++j) {
        const int q0 = (int)rintf(v[j].x * inv) + bias, q1 = (int)rintf(v[j].y * inv) + bias, q2 = (int)rintf(v[j].z * inv) + bias, q3 = (int)rintf(v[j].w * inv) + bias;
        w[j] = (unsigned)(q0 & 0xff) | ((unsigned)(q1 & 0xff) << 8) | ((unsigned)(q2 & 0xff) << 16) | ((unsigned)(q3 & 0xff) << 24);
    }
    *(v4u*)(q + lane * 16) = w;
    if (lane == 0) *scale_out = am * (1.f / 127.f);
}
__device__ __forceinline__ void gather_token(const Args& a, float* outp, int t, int idA, int idB, float gA, float gB, int lane) {
    const bf16* h2 = (const bf16*)(a.ws + WS_XN); const float* mod = (const float*)(a.ws + WS_MOD);
    const unsigned char* uq = a.ws + WS_UQ; const unsigned char* vq = a.ws + WS_VQ;
    const float* usc = (const float*)(a.ws + WS_USC); const float* vsc = (const float*)(a.ws + WS_VSC);
    const float* g_final = a.in[IN_GF];
    const int sel = (lane >> 2) & 15;
    const bool b5 = lane & 32, b4 = lane & 16, b3 = lane & 8, b2 = lane & 4;
    unsigned lane16 = (unsigned)lane * 16u; asm volatile("" : "+v"(lane16));
    const v4u* hp = (const v4u*)(h2 + (size_t)t * D + lane * 16);
    const v4u h0 = hp[0], h1 = hp[1];
    float hv[16];
#pragma unroll
    for (int j = 0; j < 4; ++j) { hv[2 * j] = bflo(h0[j]); hv[2 * j + 1] = bfhi(h0[j]); hv[8 + 2 * j] = bflo(h1[j]); hv[8 + 2 * j + 1] = bfhi(h1[j]); }
    float am = 0.f;
#pragma unroll
    for (int j = 0; j < 16; ++j) am = fmaxf(am, fabsf(hv[j]));
#pragma unroll
    for (int o = 1; o < 64; o <<= 1) am = fmaxf(am, __shfl_xor(am, o));
    const float hinv = am > 0.f ? 127.f / am : 0.f, hs = am * (1.f / 127.f);
    int hq[4];
#pragma unroll
    for (int j = 0; j < 4; ++j) {
        const int q0 = (int)rintf(hv[4 * j] * hinv), q1 = (int)rintf(hv[4 * j + 1] * hinv), q2 = (int)rintf(hv[4 * j + 2] * hinv), q3 = (int)rintf(hv[4 * j + 3] * hinv);
        hq[j] = (int)((unsigned)(q0 & 0xff) | ((unsigned)(q1 & 0xff) << 8) | ((unsigned)(q2 & 0xff) << 16) | ((unsigned)(q3 & 0xff) << 24));
    }
    const float usA = usc[idA], usB = usc[idB], vsA = vsc[idA], vsB = vsc[idB];
    float wreg[8];
#pragma unroll
    for (int bt = 0; bt < 8; ++bt) {
        v4u ub[16];
#pragma unroll
        for (int j = 0; j < 16; ++j) { const int e = bt * 16 + j; const int id = __builtin_amdgcn_readlane(e < 64 ? idA : idB, e & 63);
            ub[j] = *(const v4u*)(uq + (size_t)id * 1024 + lane16); }
        int p[16];
#pragma unroll
        for (int j = 0; j < 16; ++j)
            p[j] = __builtin_amdgcn_sdot4((int)ub[j].x, hq[0], __builtin_amdgcn_sdot4((int)ub[j].y, hq[1], __builtin_amdgcn_sdot4((int)ub[j].z, hq[2], __builtin_amdgcn_sdot4((int)ub[j].w, hq[3], 0, false), false), false), false);
        int r1[8], r2[4], r3[2];
#pragma unroll
        for (int k = 0; k < 8; ++k) r1[k] = (b5 ? p[k + 8] : p[k]) + __shfl_xor(b5 ? p[k] : p[k + 8], 32);
#pragma unroll
        for (int k = 0; k < 4; ++k) r2[k] = (b4 ? r1[k + 4] : r1[k]) + __shfl_xor(b4 ? r1[k] : r1[k + 4], 16);
#pragma unroll
        for (int k = 0; k < 2; ++k) r3[k] = (b3 ? r2[k + 2] : r2[k]) + __shfl_xor(b3 ? r2[k] : r2[k + 2], 8);
        int r4 = (b2 ? r3[1] : r3[0]) + __shfl_xor(b2 ? r3[0] : r3[1], 4);
        r4 += __shfl_xor(r4, 2); r4 += __shfl_xor(r4, 1);
        const int src = (bt * 16 + sel) & 63;
        const float us = __shfl(bt < 4 ? usA : usB, src), vs = __shfl(bt < 4 ? vsA : vsB, src), g = __shfl(bt < 4 ? gA : gB, src);
        const float dot = (float)r4 * hs * us;
        wreg[bt] = g * 0.5f * dot * (1.f + erff(dot * 0.70710678118654752f)) * vs;
    }
    float acc[16]; float sw = 0.f;
#pragma unroll
    for (int k = 0; k < 16; ++k) acc[k] = 0.f;
#pragma unroll
    for (int bt = 0; bt < 8; ++bt) {
        v4u vb[16];
#pragma unroll
        for (int j = 0; j < 16; ++j) { const int e = bt * 16 + j; const int id = __builtin_amdgcn_readlane(e < 64 ? idA : idB, e & 63);
            vb[j] = *(const v4u*)(vq + (size_t)id * 1024 + lane16); }
#pragma unroll
        for (int j = 0; j < 16; ++j) {
            const float w = __uint_as_float(__builtin_amdgcn_readlane(__float_as_uint(wreg[bt]), 4 * j));
            sw += w;
#pragma unroll
            for (int q = 0; q < 4; ++q) { const unsigned x = vb[j][q];
                acc[4 * q + 0] = fmaf(w, (float)(x & 0xff), acc[4 * q + 0]); acc[4 * q + 1] = fmaf(w, (float)((x >> 8) & 0xff), acc[4 * q + 1]);
                acc[4 * q + 2] = fmaf(w, (float)((x >> 16) & 0xff), acc[4 * q + 2]); acc[4 * q + 3] = fmaf(w, (float)(x >> 24), acc[4 * q + 3]); }
        }
    }
    const int b = t / SEQ;
#if PROBE_REP == 10
    const f32x4* xi = (const f32x4*)(a.out + (size_t)t * D) + lane * 4; f32x4* xo = (f32x4*)(outp + (size_t)t * D) + lane * 4;
#else
    f32x4* xo = (f32x4*)(a.out + (size_t)t * D) + lane * 4; const f32x4* xi = xo;
#endif
    const f32x4* g2 = (const f32x4*)(mod + b * 6144 + 5 * D) + lane * 4;
    const f32x4* gf = (const f32x4*)g_final + lane * 4;
    f32x4 x2[4]; float ss = 0.f;
#pragma unroll
    for (int q = 0; q < 4; ++q) {
        const f32x4 y = (f32x4){acc[4 * q] - 128.f * sw, acc[4 * q + 1] - 128.f * sw, acc[4 * q + 2] - 128.f * sw, acc[4 * q + 3] - 128.f * sw};
        x2[q] = xi[q] + g2[q] * y;
        ss += (x2[q].x * x2[q].x + x2[q].y * x2[q].y) + (x2[q].z * x2[q].z + x2[q].w * x2[q].w);
    }
    const float r = rsqrtf(wave_sum(ss) * (1.f / D) + EPS);
#pragma unroll
    for (int q = 0; q < 4; ++q) xo[q] = x2[q] * r * gf[q];
}

typedef float f32x16 __attribute__((ext_vector_type(16)));
typedef short bfx8 __attribute__((ext_vector_type(8)));
__device__ __forceinline__ unsigned f2ord(float f) { const unsigned u = __float_as_uint(f); return (u & 0x80000000u) ? ~u : (u | 0x80000000u); }
__device__ __forceinline__ float ord2f(unsigned o) { const unsigned u = (o & 0x80000000u) ? (o & 0x7fffffffu) : ~o; return __uint_as_float(u); }
__device__ __forceinline__ unsigned umax_(unsigned x, unsigned y) { return x > y ? x : y; }
__device__ __forceinline__ unsigned umin_(unsigned x, unsigned y) { return x < y ? x : y; }
template <int N> __device__ __forceinline__ void sort_desc(unsigned (&v)[N]) {
#pragma unroll
    for (int k = 2; k <= N; k <<= 1)
#pragma unroll
        for (int j = k >> 1; j > 0; j >>= 1)
#pragma unroll
            for (int i = 0; i < N; ++i) { const int l = i ^ j; if (l > i) { const bool desc = ((i & k) == 0); const unsigned hi = umax_(v[i], v[l]), lo = umin_(v[i], v[l]); v[i] = desc ? hi : lo; v[l] = desc ? lo : hi; } }
}
__device__ __forceinline__ void merge_top16(unsigned (&x)[16], const unsigned (&y)[16]) {
#pragma unroll
    for (int i = 0; i < 16; ++i) x[i] = umax_(x[i], y[15 - i]);
#pragma unroll
    for (int j = 8; j > 0; j >>= 1)
#pragma unroll
        for (int i = 0; i < 16; ++i) { const int l = i ^ j; if (l > i) { const unsigned hi = umax_(x[i], x[l]), lo = umin_(x[i], x[l]); x[i] = hi; x[l] = lo; } }
}
__device__ __forceinline__ bfx8 bload16(__amdgpu_buffer_rsrc_t r, unsigned voff, unsigned soff) { return __builtin_bit_cast(bfx8, __builtin_amdgcn_raw_buffer_load_b128(r, voff, soff, 0)); }
__device__ __forceinline__ void peer_level1(__amdgpu_buffer_rsrc_t qr, unsigned qoff, __amdgpu_buffer_rsrc_t kr, unsigned koff, unsigned ksoff, int hp, unsigned (&out)[16]) {
    f32x16 acc[4];
#pragma unroll
    for (int kt = 0; kt < 4; ++kt)
#pragma unroll
        for (int r = 0; r < 16; ++r) acc[kt][r] = 0.f;
#pragma unroll
    for (int s = 0; s < 8; ++s) {
        const bfx8 bq = bload16(qr, qoff + 32 * s, 0);
#pragma unroll
        for (int kt = 0; kt < 4; ++kt) { const bfx8 ak = bload16(kr, koff + 32 * s, ksoff + kt * 8192);
            acc[kt] = __builtin_amdgcn_mfma_f32_32x32x16_bf16(ak, bq, acc[kt], 0, 0, 0); }
    }
    unsigned g0[16], g1[16], g2[16], g3[16];
#pragma unroll
    for (int r = 0; r < 16; ++r) {
        const unsigned kb = (unsigned)(127 - ((r & 3) + 8 * (r >> 2) + 4 * hp));
        g0[r] = (f2ord(acc[0][r]) & ~0x7Fu) | kb; g1[r] = (f2ord(acc[1][r]) & ~0x7Fu) | (kb - 32u); g2[r] = (f2ord(acc[2][r]) & ~0x7Fu) | (kb - 64u); g3[r] = (f2ord(acc[3][r]) & ~0x7Fu) | (kb - 96u);
    }
    sort_desc<16>(g0); sort_desc<16>(g1); sort_desc<16>(g2); sort_desc<16>(g3);
    merge_top16(g0, g1); merge_top16(g2, g3); merge_top16(g0, g2);
    unsigned oth[16];
#pragma unroll
    for (int i = 0; i < 16; ++i) oth[i] = __shfl_xor(g0[i], 32);
    merge_top16(g0, oth);
#pragma unroll
    for (int i = 0; i < 16; ++i) out[i] = g0[i];
}
constexpr int TAB_OFF = 0, EID_OFF = 32768, GT_OFF = 49152;
__device__ void phase_peer(const Args& a, float* outp, int bid, int nb, unsigned char* lds) {
    const bf16* qp = (const bf16*)(a.ws + WS_QP); const bf16* keys = (const bf16*)(a.ws + WS_KEYS);
    const int tid = threadIdx.x, lane = tid & 63, wave = tid >> 6, c31 = lane & 31, hp = lane >> 5;
    unsigned* TAB = (unsigned*)(lds + TAB_OFF) + wave * 1024; int* EID = (int*)(lds + EID_OFF); float* GT = (float*)(lds + GT_OFF);
    const __amdgpu_buffer_rsrc_t qrs = __builtin_amdgcn_make_buffer_rsrc((void*)qp, (short)0, T * 2048 * 2, 0x00020000);
    const __amdgpu_buffer_rsrc_t krs = __builtin_amdgcn_make_buffer_rsrc((void*)keys, (short)0, 2 * 8 * 128 * 128 * 2, 0x00020000);
    for (int task = bid; task < T / 32; task += nb) {
        const int tok0 = task * 32, h = wave;
        unsigned top0[16], top1[16];
        {
            const unsigned qoff = (unsigned)(tok0 + c31) * 4096u + (unsigned)h * 512u + (unsigned)hp * 16u, koff = (unsigned)c31 * 256u + (unsigned)hp * 16u;
            const unsigned ks0 = (unsigned)__builtin_amdgcn_readfirstlane(h) * 32768u;
            peer_level1(qrs, qoff, krs, koff, ks0, hp, top0);
            peer_level1(qrs, qoff + 256u, krs, koff, ks0 + 262144u, hp, top1);
        }
#pragma unroll
        for (int i = 0; i < 16; ++i) TAB[i * 64 + lane] = (127u - (top0[i] & 0x7Fu)) | ((127u - (top1[i] & 0x7Fu)) << 8);
        float fa[16], fb[16];
#pragma unroll
        for (int i = 0; i < 16; ++i) { const unsigned x = hp ? top1[i] : top0[i], y = hp ? top0[i] : top1[i]; fa[i] = ord2f(x & ~0x7Fu); fb[i] = ord2f(y & ~0x7Fu); }
        unsigned c0[16], c1[16];
#pragma unroll
        for (int j = 0; j < 16; ++j) { const unsigned code = hp ? (unsigned)((j << 4) | 0) : (unsigned)j; c0[j] = (f2ord(fa[0] + fb[j]) & ~0xFFu) | code; }
        if (hp) c0[0] = 0u;
        {
            constexpr int CI[11] = {1, 1, 1, 1, 1, 1, 1, 2, 2, 2, 3}, CJ[11] = {1, 2, 3, 4, 5, 6, 7, 2, 3, 4, 3};
#pragma unroll
            for (int m = 0; m < 11; ++m) {
                const int i = CI[m], j = CJ[m];
                const unsigned code = hp ? (unsigned)((j << 4) | i) : (unsigned)((i << 4) | j);
                unsigned key = (f2ord(fa[i] + fb[j]) & ~0xFFu) | code;
                if (i == j && hp) key = 0u;
                c1[m] = key;
            }
#pragma unroll
            for (int m = 11; m < 16; ++m) c1[m] = 0u;
        }
        sort_desc<16>(c0); sort_desc<16>(c1); merge_top16(c0, c1);
        {
            unsigned oth[16];
#pragma unroll
            for (int i = 0; i < 16; ++i) oth[i] = __shfl_xor(c0[i], 32);
            merge_top16(c0, oth);
        }
        const float smax = ord2f(c0[0] & ~0xFFu);
        float ex[16], esum = 0.f;
#pragma unroll
        for (int i = 0; i < 16; ++i) { ex[i] = __expf(ord2f(c0[i] & ~0xFFu) - smax); esum += ex[i]; }
        const float rinv = 1.f / esum;
        const unsigned hmask = 0u - (unsigned)hp;
#pragma unroll
        for (int m = 0; m < 8; ++m) {
            const unsigned code = ((c0[8 + m] & hmask) | (c0[m] & ~hmask)) & 0xFFu; const float gv = __uint_as_float((__float_as_uint(ex[8 + m]) & hmask) | (__float_as_uint(ex[m]) & ~hmask)) * rinv;
            const unsigned k1 = TAB[(code >> 4) * 64 + lane] & 0xFFu, k2 = (TAB[(code & 15u) * 64 + lane] >> 8) & 0xFFu;
            EID[c31 * 128 + h * 16 + 8 * hp + m] = (int)(k1 * 128u + k2);
            GT[c31 * 128 + h * 16 + 8 * hp + m] = gv;
        }
        __syncthreads();
        for (int i = 0; i < 4; ++i) {
            const int tt = wave * 4 + i;
            gather_token(a, outp, tok0 + tt, EID[tt * 128 + lane], EID[tt * 128 + 64 + lane], GT[tt * 128 + lane], GT[tt * 128 + 64 + lane], lane);
        }
        __syncthreads();
    }
}

typedef float f32x4_t __attribute__((ext_vector_type(4)));
typedef short s16x8 __attribute__((ext_vector_type(8)));
constexpr int BCS = 68, KS = 72;
constexpr int GL_OFF = 0, BC_OFF = 4096, TOT_OFF = BC_OFF + 64 * BCS * 4, KDT_OFF = TOT_OFF + 2048, VT_OFF = KDT_OFF + 64 * KS * 2, PL_OFF = VT_OFF + 128 * KS * 2, RS_OFF = PL_OFF + 64 * KS * 2;
static_assert(RS_OFF + 1024 <= RING_BYTES, "GLA LDS map");
__device__ __forceinline__ unsigned pkbf(float lo, float hi) { typedef float f2 __attribute__((ext_vector_type(2))); typedef __bf16 b2 __attribute__((ext_vector_type(2))); f2 v = {lo, hi}; b2 b = __builtin_convertvector(v, b2); return __builtin_bit_cast(unsigned, b); }
__device__ __forceinline__ void gla_gating(const Args& a, const bf16* proj, size_t tok0, int h, unsigned char* lds) {
    float* GL = (float*)(lds + GL_OFF); float* BC = (float*)(lds + BC_OFF); float* TOT = (float*)(lds + TOT_OFF);
    const int tid = threadIdx.x, d = tid & 63, tq = tid >> 6;
    for (int i = tid; i < 64 * 16; i += NTHR) GL[i] = bf2f(proj[(tok0 + (i >> 4)) * LDP + OFF_GLR + (i & 15)]);
    float wu[16];
#pragma unroll
    for (int r = 0; r < 16; ++r) wu[r] = a.in[IN_WUP][r * 256 + h * 64 + d];
    const float bg = a.in[IN_BGATE][h * 64 + d];
    __syncthreads();
    float cum = 0.f;
#pragma unroll
    for (int i = 0; i < 8; ++i) {
        const int t = 8 * tq + i; float x = bg;
#pragma unroll
        for (int r = 0; r < 16; ++r) x += GL[t * 16 + r] * wu[r];
        cum += -softplusf(-x) * (1.f / 16.f);
        BC[t * BCS + d] = cum;
    }
    TOT[tq * 64 + d] = cum;
    __syncthreads();
    float off = 0.f;
    for (int g = 0; g < tq; ++g) off += TOT[g * 64 + d];
#pragma unroll
    for (int i = 0; i < 8; ++i) BC[(8 * tq + i) * BCS + d] += off;
    __syncthreads();
}
__device__ __forceinline__ void gla_stage_vt(const bf16* proj, size_t tok0, int h, unsigned char* lds) {
    bf16* VT = (bf16*)(lds + VT_OFF);
    const int tid = threadIdx.x, s = tid >> 3, dv0 = (tid & 7) * 16;
    const v4u* vp = (const v4u*)(proj + (tok0 + s) * LDP + OFF_GV + h * 128 + dv0);
    const v4u v0 = vp[0], v1 = vp[1];
#pragma unroll
    for (int j = 0; j < 4; ++j) { VT[(dv0 + 2 * j) * KS + s] = (bf16)(v0[j] & 0xffffu); VT[(dv0 + 2 * j + 1) * KS + s] = (bf16)(v0[j] >> 16);
                                  VT[(dv0 + 8 + 2 * j) * KS + s] = (bf16)(v1[j] & 0xffffu); VT[(dv0 + 8 + 2 * j + 1) * KS + s] = (bf16)(v1[j] >> 16); }
}
__device__ void phase_gla_local(const Args& a, int bid, int nb, unsigned char* lds) {
    const bf16* proj = (const bf16*)(a.ws + WS_PROJ);
    float* DS = (float*)((unsigned char*)a.out + DO_DS); float* GS = (float*)((unsigned char*)a.out + DO_GS);
    const float* BC = (const float*)(lds + BC_OFF); bf16* KDT = (bf16*)(lds + KDT_OFF); const bf16* VT = (const bf16*)(lds + VT_OFF);
    const int tid = threadIdx.x, lane = tid & 63, wave = tid >> 6, fr = lane & 15, fq = lane >> 4;
    for (int u = bid; u < 1024; u += nb) {
        const int h = u & 3, bc = u >> 2; const size_t tok0 = (size_t)bc * 64;
        gla_gating(a, proj, tok0, h, lds);
        {
            const int s = tid >> 3, d0 = (tid & 7) * 8;
            const v4u kv = *(const v4u*)(proj + (tok0 + s) * LDP + OFF_GK + h * 64 + d0);
#pragma unroll
            for (int j = 0; j < 4; ++j) {
                const float e0 = __expf(BC[63 * BCS + d0 + 2 * j] - BC[s * BCS + d0 + 2 * j]), e1 = __expf(BC[63 * BCS + d0 + 2 * j + 1] - BC[s * BCS + d0 + 2 * j + 1]);
                KDT[(d0 + 2 * j) * KS + s] = (bf16)f2bf(bflo(kv[j]) * e0); KDT[(d0 + 2 * j + 1) * KS + s] = (bf16)f2bf(bfhi(kv[j]) * e1);
            }
        }
        gla_stage_vt(proj, tok0, h, lds);
        if (tid < 64) GS[(size_t)u * 64 + tid] = __expf(BC[63 * BCS + tid]);
        __syncthreads();
        {
            f32x4_t acc[4];
#pragma unroll
            for (int mt = 0; mt < 4; ++mt) acc[mt] = (f32x4_t){0.f, 0.f, 0.f, 0.f};
#pragma unroll
            for (int ks = 0; ks < 2; ++ks) {
                const s16x8 bfrag = *(const s16x8*)(VT + (16 * wave + fr) * KS + 32 * ks + 8 * fq);
#pragma unroll
                for (int mt = 0; mt < 4; ++mt) { const s16x8 afrag = *(const s16x8*)(KDT + (16 * mt + fr) * KS + 32 * ks + 8 * fq);
                    acc[mt] = __builtin_amdgcn_mfma_f32_16x16x32_bf16(afrag, bfrag, acc[mt], 0, 0, 0); }
            }
            float* dst = DS + ((size_t)u * 128 + 16 * wave + fr) * 64 + 4 * fq;
#pragma unroll
            for (int mt = 0; mt < 4; ++mt) *(f32x4_t*)(dst + 16 * mt) = acc[mt];
        }
        __syncthreads();
    }
}
__device__ void phase_gla_scan(const Args& a, int bid, int nb) {
    const float* DS = (const float*)((unsigned char*)a.out + DO_DS); const float* GS = (const float*)((unsigned char*)a.out + DO_GS);
    bf16* SST = (bf16*)((unsigned char*)a.out + DO_SST);
    for (int e = bid * NTHR + threadIdx.x; e < 8 * 8192; e += nb * NTHR) {
        const int bh = e >> 13, el = e & 8191, dk = el & 63, b = bh >> 2, h = bh & 3;
        float S = 0.f;
#pragma unroll 8
        for (int c = 0; c < 128; ++c) {
            const size_t u = (size_t)(b * 128 + c) * 4 + h;
            SST[u * 8192 + el] = (bf16)f2bf(S);
            S = S * GS[u * 64 + dk] + DS[u * 8192 + el];
        }
    }
}
__device__ void phase_gla_out(const Args& a, int bid, int nb, unsigned char* lds) {
    const bf16* proj = (const bf16*)(a.ws + WS_PROJ); bf16* mixin = (bf16*)(a.ws + WS_MIXIN);
    const bf16* SST = (const bf16*)((unsigned char*)a.out + DO_SST); const float* g_gla = a.in[IN_GGLA];
    const float* BC = (const float*)(lds + BC_OFF); const bf16* VT = (const bf16*)(lds + VT_OFF); bf16* PL = (bf16*)(lds + PL_OFF); float* RS = (float*)(lds + RS_OFF);
    const int tid = threadIdx.x, lane = tid & 63, wave = tid >> 6, fr = lane & 15, fq = lane >> 4;
    const int nt = wave & 3, wh = wave >> 2;
    for (int u = bid; u < 1024; u += nb) {
        const int h = u & 3, bc = u >> 2; const size_t tok0 = (size_t)bc * 64;
        gla_gating(a, proj, tok0, h, lds);
        gla_stage_vt(proj, tok0, h, lds);
        s16x8 qi[2], qo[2];
        {
            const int t = 16 * nt + fr;
#pragma unroll
            for (int ks = 0; ks < 2; ++ks) {
                const int d0 = 32 * ks + 8 * fq;
                const v4u qv = *(const v4u*)(proj + (tok0 + t) * LDP + OFF_GQ + h * 64 + d0);
                v4u wi, wo;
#pragma unroll
                for (int j = 0; j < 4; ++j) {
                    const float b0 = BC[t * BCS + d0 + 2 * j], b1 = BC[t * BCS + d0 + 2 * j + 1], r0 = BC[31 * BCS + d0 + 2 * j], r1 = BC[31 * BCS + d0 + 2 * j + 1];
                    const float q0 = bflo(qv[j]) * 0.125f, q1 = bfhi(qv[j]) * 0.125f;
                    wi[j] = pkbf(q0 * __expf(b0 - r0), q1 * __expf(b1 - r1)); wo[j] = pkbf(q0 * __expf(b0), q1 * __expf(b1));
                }
                qi[ks] = __builtin_bit_cast(s16x8, wi); qo[ks] = __builtin_bit_cast(s16x8, wo);
            }
        }
#pragma unroll
        for (int mi = 0; mi < 2; ++mi) {
            const int ms = wh + 2 * mi, s = 16 * ms + fr;
            f32x4_t acc = (f32x4_t){0.f, 0.f, 0.f, 0.f};
#pragma unroll
            for (int ks = 0; ks < 2; ++ks) {
                const int d0 = 32 * ks + 8 * fq;
                const v4u kv = *(const v4u*)(proj + (tok0 + s) * LDP + OFF_GK + h * 64 + d0);
                v4u wk;
#pragma unroll
                for (int j = 0; j < 4; ++j) {
                    const float e0 = __expf(BC[31 * BCS + d0 + 2 * j] - BC[s * BCS + d0 + 2 * j]), e1 = __expf(BC[31 * BCS + d0 + 2 * j + 1] - BC[s * BCS + d0 + 2 * j + 1]);
                    wk[j] = pkbf(bflo(kv[j]) * e0, bfhi(kv[j]) * e1);
                }
                acc = __builtin_amdgcn_mfma_f32_16x16x32_bf16(__builtin_bit_cast(s16x8, wk), qi[ks], acc, 0, 0, 0);
            }
            const int t = 16 * nt + fr, s0 = 16 * ms + 4 * fq;
            const float p0 = (s0 + 0 <= t) ? acc[0] : 0.f, p1 = (s0 + 1 <= t) ? acc[1] : 0.f, p2 = (s0 + 2 <= t) ? acc[2] : 0.f, p3 = (s0 + 3 <= t) ? acc[3] : 0.f;
            *(uint2*)(PL + t * KS + s0) = make_uint2(pkbf(p0, p1), pkbf(p2, p3));
        }
        __syncthreads();
        f32x4_t o[4];
#pragma unroll
        for (int i = 0; i < 4; ++i) o[i] = (f32x4_t){0.f, 0.f, 0.f, 0.f};
#pragma unroll
        for (int ks = 0; ks < 2; ++ks) {
            const s16x8 pfrag = *(const s16x8*)(PL + (16 * nt + fr) * KS + 32 * ks + 8 * fq);
#pragma unroll
            for (int i = 0; i < 4; ++i) {
                const int dv = 16 * (4 * wh + i) + fr;
                const s16x8 vfrag = *(const s16x8*)(VT + dv * KS + 32 * ks + 8 * fq);
                const s16x8 sfrag = *(const s16x8*)(SST + (size_t)u * 8192 + dv * 64 + 32 * ks + 8 * fq);
                o[i] = __builtin_amdgcn_mfma_f32_16x16x32_bf16(vfrag, pfrag, o[i], 0, 0, 0);
                o[i] = __builtin_amdgcn_mfma_f32_16x16x32_bf16(sfrag, qo[ks], o[i], 0, 0, 0);
            }
        }
        float ss = 0.f;
#pragma unroll
        for (int i = 0; i < 4; ++i) ss += (o[i][0] * o[i][0] + o[i][1] * o[i][1]) + (o[i][2] * o[i][2] + o[i][3] * o[i][3]);
        ss += __shfl_xor(ss, 16); ss += __shfl_xor(ss, 32);
        if (fq == 0) RS[wh * 64 + 16 * nt + fr] = ss;
        __syncthreads();
        {
            const int t = 16 * nt + fr;
            const float r = rsqrtf((RS[t] + RS[64 + t]) * (1.f / 128.f) + EPS);
            const bf16* gr = proj + (tok0 + t) * LDP + OFF_GR + h * 128;
            bf16* orow = mixin + (tok0 + t) * D + 512 + h * 128;
#pragma unroll
            for (int i = 0; i < 4; ++i) {
                const int dv = 16 * (4 * wh + i) + 4 * fq;
                const uint2 gw = *(const uint2*)(gr + dv);
                const f32x4_t gg = *(const f32x4_t*)(g_gla + h * 128 + dv);
                const float v0 = o[i][0] * r * gg[0] * siluf(bflo(gw.x)), v1 = o[i][1] * r * gg[1] * siluf(bfhi(gw.x));
                const float v2 = o[i][2] * r * gg[2] * siluf(bflo(gw.y)), v3 = o[i][3] * r * gg[3] * siluf(bfhi(gw.y));
                *(uint2*)(orow + dv) = make_uint2(pkbf(v0, v1), pkbf(v2, v3));
            }
        }
        __syncthreads();
    }
}

__global__ void __launch_bounds__(NTHR, 2) fwd_megakernel(Args a) {
    extern __shared__ __attribute__((aligned(16))) unsigned char lds[];
    LAS unsigned char* L = (LAS unsigned char*)lds;
    const int tid = threadIdx.x, lane = tid & 63, wave = __builtin_amdgcn_readfirstlane(tid >> 6);
    const int bid = blockIdx.x, G = gridDim.x;
    for (int u = tid; u < (LDS_BYTES - RING_BYTES) / 4; u += NTHR) ((LAS unsigned*)(L + RING_BYTES))[u] = 0u;
    __syncthreads();
    XcdBarrier bar = xcd_barrier_post((unsigned*)(a.ws + WS_CTL) + CW_BAR, (volatile LAS unsigned*)(L + MISC_OFF) + 8);
    bf16* XN = (bf16*)(a.ws + WS_XN); bf16* WI = (bf16*)(a.ws + WS_WI); bf16* WO = (bf16*)(a.ws + WS_WO); bf16* WPQ = (bf16*)(a.ws + WS_WPQ);

    for (int rep = 0; rep < NREP(0); ++rep) {
        LAS float* scr = (LAS float*)(L + wave * 16384);
        const int gw = bid * NWAVES + wave, NGW = G * NWAVES;
        constexpr int I_IN = (D / 64) * (NPAD / 32), I_OUT = (D / 64) * (D / 32), I_PQ = (D / 64) * (2048 / 32);
        for (int it = gw; it < I_IN + I_OUT + I_PQ; it += NGW) {
            int r = it;
            if (r < I_IN) { transpose_item<true>(a.in[IN_WIN], D, NPROJ, NPAD, WI, scr, r, lane); continue; } r -= I_IN;
            if (r < I_OUT) { transpose_item<false>(a.in[IN_WOUT], D, D, D, WO, scr, r, lane); continue; } r -= I_OUT;
            transpose_item<false>(a.in[IN_WPQ], D, 2048, 2048, WPQ, scr, r, lane);
        }
        for (int r = gw; r < 2 * 16384; r += NGW) {
            if (r < 16384) quant_row(a.in[IN_PU] + (size_t)r * D, a.ws + WS_UQ + (size_t)r * 1024, (float*)(a.ws + WS_USC) + r, 0, lane);
            else { const int rr = r - 16384; quant_row(a.in[IN_PV] + (size_t)rr * D, a.ws + WS_VQ + (size_t)rr * 1024, (float*)(a.ws + WS_VSC) + rr, 128, lane); }
        }
        for (int i = bid * NTHR + tid; i < 2 * 8 * 128 * 128; i += G * NTHR) {
            const int w = i >> 17, j = i & 131071;
            ((bf16*)(a.ws + WS_KEYS))[i] = (bf16)f2bf((w ? a.in[IN_KB] : a.in[IN_KA])[j]);
        }
        __syncthreads();
        phase_mod(a, bid, G, lds);
        xcd_barrier(bar);
    }
    for (int rep = 0; rep < NREP(1); ++rep) { phase_norm(a, a.in[IN_X], XN, 0, D, bid, G); xcd_barrier(bar); }
    for (int rep = 0; rep < NREP(2); ++rep) {
        pg8::Gemm g{XN, XN, T + NPAD, T + NPAD, D}; pg8::ProjOrder S; S.init(G, bid);
        pg8::EpiProj E{(bf16*)(a.ws + WS_PROJ), (bf16*)(a.ws + WS_VT)};
        pg8::gemm_phase<pg8::EpiProj, pg8::ProjOrder, true, true>(L, g, S, E);
        xcd_barrier(bar);
    }
    for (int rep = 0; rep < NREP(3); ++rep) phase_sb(a, bid, G);
    for (int rep = 0; rep < NREP(4); ++rep) { phase_gla_local(a, bid, G, lds); xcd_barrier(bar); }
    for (int rep = 0; rep < NREP(5); ++rep) { phase_gla_scan(a, bid, G); xcd_barrier(bar); }
    for (int rep = 0; rep < NREP(6); ++rep) { phase_gla_out(a, bid, G, lds); xcd_barrier(bar); }
    for (int rep = 0; rep < NREP(7); ++rep) {
        pg8::Gemm g{(const bf16*)(a.ws + WS_MIXIN), WO, T, D, D}; pg8::StaticOrder S; S.init(T, D, G, bid);
        pg8::EpiResF32 E{a.in[IN_X], (const float*)(a.ws + WS_MOD), a.out, 2 * D};
        pg8::gemm_phase<pg8::EpiResF32, pg8::StaticOrder, true, true>(L, g, S, E);
        xcd_barrier(bar);
    }
    for (int rep = 0; rep < NREP(8); ++rep) { phase_norm(a, a.out, XN, 3 * D, 4 * D, bid, G); xcd_barrier(bar); }
    for (int rep = 0; rep < NREP(9); ++rep) {
        pg8::Gemm g{XN, WPQ, T, 2048, D}; pg8::StaticOrder S; S.init(T, 2048, G, bid);
        pg8::EpiStoreBf16 E{(bf16*)(a.ws + WS_QP), 2048};
        pg8::gemm_phase<pg8::EpiStoreBf16, pg8::StaticOrder, true, true>(L, g, S, E);
        xcd_barrier(bar);
    }
    if (NREP(10) == 2) { phase_peer(a, (float*)(a.ws + 112 * MiB), bid, G, lds); xcd_barrier(bar); }
    phase_peer(a, a.out, bid, G, lds);
}

extern "C" void kernel_launch(void* const* d_in, const int* in_sizes, int n_in, void* d_out, int out_size, void* d_ws, size_t ws_size, hipStream_t stream) {
    static int grid = 0;
    if (grid == 0) {
        int dev = 0, cus = 0;
        if (hipGetDevice(&dev) != hipSuccess || hipDeviceGetAttribute(&cus, hipDeviceAttributeMultiprocessorCount, dev) != hipSuccess) { fprintf(stderr, "kernel_launch: device query failed\n"); grid = -1; return; }
        if (hipFuncSetAttribute((const void*)fwd_megakernel, hipFuncAttributeMaxDynamicSharedMemorySize, LDS_BYTES) != hipSuccess) { fprintf(stderr, "kernel_launch: hipFuncSetAttribute failed\n"); grid = -1; return; }
        int per_cu = 0;
        if (hipOccupancyMaxActiveBlocksPerMultiprocessor(&per_cu, (const void*)fwd_megakernel, NTHR, LDS_BYTES) != hipSuccess || per_cu < 1) fprintf(stderr, "kernel_launch: occupancy query reports %d\n", per_cu);
        (void)hipGetLastError();
        grid = cus;
    }
    if (grid < 0) return;
    (void)hipMemsetAsync((char*)d_ws + WS_CTL, 0, CTL_ZERO_BYTES, stream);
    Args a{};
    for (int i = 0; i < 16; ++i) a.in[i] = (const float*)d_in[i];
    a.out = (float*)d_out; a.ws = (unsigned char*)d_ws;
    hipLaunchKernelGGL(fwd_megakernel, dim3(grid), dim3(NTHR), LDS_BYTES, stream, a);
}
```
